# Optimizing an MI355X kernel written in HIP

```python
import math
import jax
import jax.numpy as jnp
from jax import lax
import numpy as np

D_MODEL = 1024
BATCH = 8
SEQ = 4096
DEPTH = 4
DEC_BATCH = 1
DEC_SEQ = 16384
PAST_LEN = 128

GRID_W = 64
NA_HEADS = 4
NA_HEAD_DIM = 64
NA_WIDTH = NA_HEADS * NA_HEAD_DIM
NA_ROWS = 8
NA_COLS = 16
NA_QCOLS = 16
NA_KCOLS = 2 * NA_COLS
NA_NCB = GRID_W // NA_QCOLS
MLA_HEADS = 8
MLA_NOPE = 64
MLA_ROPE = 32
MLA_V = 64
MLA_Q_LORA = 384
MLA_KV_LORA = 256
MLA_WIDTH = MLA_HEADS * MLA_V
ROPE_BASE = 10000.0
Q_BLOCK = 128
SSM_GROUPS = 16
SSM_GC = 16
SSM_STATE = 64
SSM_WIDTH = SSM_GROUPS * SSM_GC
DT_MIN = 0.001
DT_MAX = 0.1
MIX_WIDTH = NA_WIDTH + MLA_WIDTH + SSM_WIDTH
N_IN = 3 * NA_WIDTH + MLA_Q_LORA + MLA_KV_LORA + MLA_ROPE + SSM_WIDTH
FFN_HIDDEN = -(-8 * D_MODEL // (3 * 256)) * 256
RMS_EPS = 1e-6
NEG_INF = -1e30

kernel_name = 'hybrid_bidir_na_mla_s5_encoder'


def _rms_norm(x, g):
    xf = x.astype(jnp.float32)
    y = xf * lax.rsqrt(jnp.mean(xf * xf, axis=-1, keepdims=True) + RMS_EPS)
    return (y * g.astype(jnp.float32)).astype(x.dtype)


def _rope_tables(length):
    inv = 1.0 / (ROPE_BASE ** (jnp.arange(0, MLA_ROPE, 2, dtype=jnp.float32) / MLA_ROPE))
    ang = jnp.arange(length, dtype=jnp.float32)[:, None] * inv[None, :]
    return jnp.cos(ang), jnp.sin(ang)


def _apply_rope(x, cos, sin):
    xf = x.astype(jnp.float32)
    half = xf.shape[-1] // 2
    x1, x2 = xf[..., :half], xf[..., half:]
    return jnp.concatenate([x1 * cos - x2 * sin, x1 * sin + x2 * cos], axis=-1).astype(x.dtype)


def _neighborhood_attention(q, k, v, rpb):
    b, length, h, d = q.shape
    rows = length // GRID_W
    kh = min(NA_ROWS, rows)
    r = np.arange(rows)
    row_idx = np.clip(r - kh // 2, 0, rows - kh)[:, None] + np.arange(kh)[None, :]
    dr_idx = row_idx - r[:, None] + (NA_ROWS - 1)
    cb = np.arange(NA_NCB)
    kc0 = np.clip(cb * NA_QCOLS - NA_COLS // 2, 0, GRID_W - NA_KCOLS)
    col_idx = kc0[:, None] + np.arange(NA_KCOLS)[None, :]
    qcol = cb[:, None] * NA_QCOLS + np.arange(NA_QCOLS)[None, :]
    cs = np.clip(qcol - NA_COLS // 2, 0, GRID_W - NA_COLS)[:, :, None]
    kcol = col_idx[:, None, :]
    col_mask = (kcol >= cs) & (kcol < cs + NA_COLS)
    dc_idx = np.clip(kcol - qcol[:, :, None], -(NA_COLS - 1), NA_COLS - 1) + (NA_COLS - 1)
    bias = rpb.astype(jnp.float32)[:, dr_idx[:, None, None, :, None], dc_idx[None, :, :, None, :]]
    kg = k.reshape(b, rows, GRID_W, h, d)[:, row_idx][:, :, :, col_idx]
    vg = v.reshape(b, rows, GRID_W, h, d)[:, row_idx][:, :, :, col_idx]
    qg = q.reshape(b, rows, NA_NCB, NA_QCOLS, h, d)
    s = jnp.einsum('brcqhd,brkcjhd->bhrcqkj', qg, kg).astype(jnp.float32) * (d ** -0.5)
    s = jnp.where(col_mask[:, :, None, :], s + bias[None], NEG_INF)
    p = jax.nn.softmax(s.reshape(s.shape[:-2] + (kh * NA_KCOLS,)), axis=-1).reshape(s.shape).astype(v.dtype)
    o = jnp.einsum('bhrcqkj,brkcjhd->brcqhd', p, vg)
    return o.reshape(b, length, h * d)


def _mla_attention(qn, qr, kn, kr, v):
    b, length, h, _ = qn.shape
    nb = length // Q_BLOCK
    scale = (MLA_NOPE + MLA_ROPE) ** -0.5

    def blocks(t):
        return jnp.moveaxis(t.reshape((b, nb, Q_BLOCK) + t.shape[2:]), 1, 0)

    def attend(qs):
        qn_i, qr_i = qs
        s = (jnp.einsum('bqhd,bkhd->bhqk', qn_i, kn)
             + jnp.einsum('bqhr,bkr->bhqk', qr_i, kr)).astype(jnp.float32) * scale
        p = jax.nn.softmax(s, axis=-1).astype(v.dtype)
        return jnp.einsum('bhqk,bkhd->bqhd', p, v)

    o = lax.map(attend, (blocks(qn), blocks(qr)))
    return jnp.moveaxis(o, 0, 1).reshape(b, length, h * MLA_V)


def _linear_recurrence_combine(left, right):
    a_l, b_l = left
    a_r, b_r = right
    return a_r * a_l, a_r * b_l + b_r


def _s5_direction(ug, a_re, a_im, b_re, b_im, c_re, c_im, log_dt, reverse):
    lam = lax.complex(a_re.astype(jnp.float32), a_im.astype(jnp.float32))
    dt = jnp.exp(log_dt.astype(jnp.float32))[:, None]
    lam_bar = jnp.exp(lam * dt)
    b_bar = ((lam_bar - 1.0) / lam)[:, :, None] * lax.complex(b_re.astype(jnp.float32), b_im.astype(jnp.float32))
    bu = jnp.einsum('gpc,blgc->blgp', b_bar, ug.astype(jnp.complex64))
    a = jnp.broadcast_to(lam_bar, bu.shape)
    _, states = lax.associative_scan(_linear_recurrence_combine, (a, bu), reverse=reverse, axis=1)
    c_mat = lax.complex(c_re.astype(jnp.float32), c_im.astype(jnp.float32))
    return jnp.einsum('gcp,blgp->blgc', c_mat, states).real


def _layer(x, c, ada_w, ada_b, norm1_g, w_in, na_q_g, na_k_g, na_rpb, mla_cq_g, mla_ckv_g,
           mla_w_uq, mla_w_ukv, mla_qn_g, mla_kn_g, mla_qr_g, mla_kr_g, ssm_a_re, ssm_a_im,
           ssm_b_re, ssm_b_im, ssm_c_re, ssm_c_im, ssm_log_dt, ssm_d, glu_w, glu_b, w_out,
           norm2_g, ffn_w_gate, ffn_w_up, ffn_w_down):
    b, length, _ = x.shape
    mod = jax.nn.silu(c) @ ada_w + ada_b
    shift1, scale1, gate1, shift2, scale2, gate2 = jnp.split(mod[:, None, :], 6, axis=-1)
    h = _rms_norm(x, norm1_g) * (1 + scale1) + shift1
    z = h @ w_in
    o1 = 3 * NA_WIDTH
    o2 = o1 + MLA_Q_LORA
    o3 = o2 + MLA_KV_LORA
    o4 = o3 + MLA_ROPE
    na_q, na_k, na_v, c_q, c_kv, k_rope, u = jnp.split(z, [NA_WIDTH, 2 * NA_WIDTH, o1, o2, o3, o4], axis=-1)

    hs = (b, length, NA_HEADS, NA_HEAD_DIM)
    y_na = _neighborhood_attention(_rms_norm(na_q.reshape(hs), na_q_g),
                                   _rms_norm(na_k.reshape(hs), na_k_g),
                                   na_v.reshape(hs), na_rpb)

    q = (_rms_norm(c_q, mla_cq_g) @ mla_w_uq).reshape(b, length, MLA_HEADS, MLA_NOPE + MLA_ROPE)
    kv = (_rms_norm(c_kv, mla_ckv_g) @ mla_w_ukv).reshape(b, length, MLA_HEADS, MLA_NOPE + MLA_V)
    cos, sin = _rope_tables(length)
    qn = _rms_norm(q[..., :MLA_NOPE], mla_qn_g)
    qr = _apply_rope(_rms_norm(q[..., MLA_NOPE:], mla_qr_g), cos[:, None, :], sin[:, None, :])
    kn = _rms_norm(kv[..., :MLA_NOPE], mla_kn_g)
    kr = _apply_rope(_rms_norm(k_rope, mla_kr_g), cos, sin)
    y_mla = _mla_attention(qn, qr, kn, kr, kv[..., MLA_NOPE:])

    ug = u.reshape(b, length, SSM_GROUPS, SSM_GC).astype(jnp.float32)
    ys = (_s5_direction(ug, ssm_a_re[0], ssm_a_im[0], ssm_b_re[0], ssm_b_im[0], ssm_c_re[0], ssm_c_im[0], ssm_log_dt[0], False)
          + _s5_direction(ug, ssm_a_re[1], ssm_a_im[1], ssm_b_re[1], ssm_b_im[1], ssm_c_re[1], ssm_c_im[1], ssm_log_dt[1], True)
          + ssm_d.astype(jnp.float32).reshape(SSM_GROUPS, SSM_GC) * ug)
    ys = jax.nn.gelu(ys.reshape(b, length, SSM_WIDTH)).astype(x.dtype)
    y_ssm = ys * jax.nn.sigmoid(ys @ glu_w + glu_b)

    mix = jnp.concatenate([y_na, y_mla, y_ssm], axis=-1) @ w_out
    x = x + gate1 * mix
    h2 = _rms_norm(x, norm2_g) * (1 + scale2) + shift2
    ffn = (jax.nn.silu(h2 @ ffn_w_gate) * (h2 @ ffn_w_up)) @ ffn_w_down
    return x + gate2 * ffn


def _trunk(x, c, params):
    for i in range(DEPTH):
        x = _layer(x, c, *[p[i] for p in params])
    return x


def setup_inputs(seed: int = 0) -> dict:
    key = jax.random.key(seed)
    ks = iter(jax.random.split(key, 40))
    f32 = jnp.float32
    d = D_MODEL

    def nrm(shape, scale):
        return scale * jax.random.normal(next(ks), shape, f32)

    def gain(shape):
        return 1.0 + 0.05 * jax.random.normal(next(ks), shape, f32)

    ssm_shape = (DEPTH, 2, SSM_GROUPS, SSM_STATE)
    return {
        'x_prompt': nrm((BATCH, SEQ, d), 1.0),
        'x_sample': nrm((DEC_BATCH, DEC_SEQ, d), 1.0),
        'c_prompt': nrm((BATCH, d), 1.0),
        'c_sample': nrm((DEC_BATCH, d), 1.0),
        'ada_w': nrm((DEPTH, d, 6 * d), 0.5 * d ** -0.5),
        'ada_b': nrm((DEPTH, 6 * d), 0.01),
        'norm1_g': gain((DEPTH, d)),
        'w_in': nrm((DEPTH, d, N_IN), d ** -0.5),
        'na_q_g': gain((DEPTH, NA_HEAD_DIM)),
        'na_k_g': gain((DEPTH, NA_HEAD_DIM)),
        'na_rpb': nrm((DEPTH, NA_HEADS, 2 * NA_ROWS - 1, 2 * NA_COLS - 1), 0.1),
        'mla_cq_g': gain((DEPTH, MLA_Q_LORA)),
        'mla_ckv_g': gain((DEPTH, MLA_KV_LORA)),
        'mla_w_uq': nrm((DEPTH, MLA_Q_LORA, MLA_HEADS * (MLA_NOPE + MLA_ROPE)), MLA_Q_LORA ** -0.5),
        'mla_w_ukv': nrm((DEPTH, MLA_KV_LORA, MLA_HEADS * (MLA_NOPE + MLA_V)), MLA_KV_LORA ** -0.5),
        'mla_qn_g': gain((DEPTH, MLA_NOPE)),
        'mla_kn_g': gain((DEPTH, MLA_NOPE)),
        'mla_qr_g': gain((DEPTH, MLA_ROPE)),
        'mla_kr_g': gain((DEPTH, MLA_ROPE)),
        'ssm_a_re': -0.5 + nrm(ssm_shape, 0.01),
        'ssm_a_im': jnp.pi * jnp.arange(SSM_STATE, dtype=f32) + nrm(ssm_shape, 0.01),
        'ssm_b_re': nrm(ssm_shape + (SSM_GC,), (2 * SSM_GC) ** -0.5),
        'ssm_b_im': nrm(ssm_shape + (SSM_GC,), (2 * SSM_GC) ** -0.5),
        'ssm_c_re': nrm((DEPTH, 2, SSM_GROUPS, SSM_GC, SSM_STATE), (2 * SSM_STATE) ** -0.5),
        'ssm_c_im': nrm((DEPTH, 2, SSM_GROUPS, SSM_GC, SSM_STATE), (2 * SSM_STATE) ** -0.5),
        'ssm_log_dt': jax.random.uniform(next(ks), (DEPTH, 2, SSM_GROUPS), f32, math.log(DT_MIN), math.log(DT_MAX)),
        'ssm_d': nrm((DEPTH, SSM_WIDTH), 1.0),
        'glu_w': nrm((DEPTH, SSM_WIDTH, SSM_WIDTH), SSM_WIDTH ** -0.5),
        'glu_b': nrm((DEPTH, SSM_WIDTH), 0.01),
        'w_out': nrm((DEPTH, MIX_WIDTH, d), MIX_WIDTH ** -0.5),
        'norm2_g': gain((DEPTH, d)),
        'ffn_w_gate': nrm((DEPTH, d, FFN_HIDDEN), d ** -0.5),
        'ffn_w_up': nrm((DEPTH, d, FFN_HIDDEN), d ** -0.5),
        'ffn_w_down': nrm((DEPTH, FFN_HIDDEN, d), FFN_HIDDEN ** -0.5),
    }


def reference(x_prompt, x_sample, c_prompt, c_sample, ada_w, ada_b, norm1_g, w_in, na_q_g, na_k_g,
              na_rpb, mla_cq_g, mla_ckv_g, mla_w_uq, mla_w_ukv, mla_qn_g, mla_kn_g, mla_qr_g,
              mla_kr_g, ssm_a_re, ssm_a_im, ssm_b_re, ssm_b_im, ssm_c_re, ssm_c_im, ssm_log_dt,
              ssm_d, glu_w, glu_b, w_out, norm2_g, ffn_w_gate, ffn_w_up, ffn_w_down):
    params = (ada_w, ada_b, norm1_g, w_in, na_q_g, na_k_g, na_rpb, mla_cq_g, mla_ckv_g,
              mla_w_uq, mla_w_ukv, mla_qn_g, mla_kn_g, mla_qr_g, mla_kr_g, ssm_a_re, ssm_a_im,
              ssm_b_re, ssm_b_im, ssm_c_re, ssm_c_im, ssm_log_dt, ssm_d, glu_w, glu_b, w_out,
              norm2_g, ffn_w_gate, ffn_w_up, ffn_w_down)
    y_prompt = _trunk(x_prompt, c_prompt, params)
    y_sample = _trunk(x_sample, c_sample, params)
    return (y_prompt, y_sample)
```

```cpp
#include <hip/hip_runtime.h>
#include <hip/hip_cooperative_groups.h>
#include <cstdio>
#include <cstdint>
namespace cg = cooperative_groups;

typedef unsigned short u16;
typedef __attribute__((ext_vector_type(8))) short bf16x8;
typedef __attribute__((ext_vector_type(16))) float f32x16;
typedef __attribute__((ext_vector_type(2))) __bf16 bf2_t;
typedef __attribute__((ext_vector_type(2))) float f2_t;
#define DI __device__ __forceinline__
#define MFMA(a, b, c) __builtin_amdgcn_mfma_f32_32x32x16_bf16((a), (b), (c), 0, 0, 0)

#ifndef DUPMASK
#define DUPMASK 0
#endif
constexpr int NTH = 512;
constexpr int TT = 49152, TP = 32768, NSEQ = 9, DEPTH = 4, FH = 2816;
constexpr float RMS_EPS = 1e-6f;
constexpr float LOG2E = 1.4426950408889634f;
constexpr float QS_NA = 0.125f * LOG2E;
constexpr float QS_MLA = 0.10206207261596575f * LOG2E;

constexpr size_t AL(size_t x) { return (x + 255) & ~(size_t)255; }
constexpr size_t O_MOD = 0;
constexpr size_t O_ROPE = O_MOD + AL((size_t)DEPTH * NSEQ * 6144 * 4);
constexpr size_t O_ETAB = O_ROPE + AL((size_t)16384 * 32 * 4);
constexpr size_t O_BBAR = O_ETAB + AL((size_t)DEPTH * 16 * 2 * 64 * 33 * 8);
constexpr size_t O_KTAB = O_BBAR + AL((size_t)DEPTH * 16 * 2 * 64 * 16 * 8);
constexpr size_t O_SSQ = O_KTAB + AL((size_t)DEPTH * 16 * 2 * 32 * 256 * 4);
constexpr size_t O_WIN = O_SSQ + AL((size_t)TT * 16 * 4);
constexpr size_t O_WUQ = O_WIN + AL((size_t)1792 * 1024 * 2);
constexpr size_t O_WUKV = O_WUQ + AL((size_t)768 * 384 * 2);
constexpr size_t O_WGLU = O_WUKV + AL((size_t)1024 * 256 * 2);
constexpr size_t O_WOUT = O_WGLU + AL((size_t)256 * 256 * 2);
constexpr size_t O_WGU = O_WOUT + AL((size_t)1024 * 1024 * 2);
constexpr size_t O_WDN = O_WGU + AL((size_t)5632 * 1024 * 2);
constexpr size_t O_KT = O_WDN + AL((size_t)1024 * 2816 * 2);
constexpr size_t O_MINT = O_KT + AL((size_t)16 * 512 * 768 * 2);
constexpr size_t O_R1 = O_MINT + AL((size_t)16 * 256 * 512 * 2);
constexpr size_t O_SLOC = O_R1 + AL((size_t)TT * 1024 * 2);
constexpr size_t O_X = O_SLOC + AL((size_t)1536 * 16 * 256 * 4);
constexpr size_t O_NAQ = O_X;
constexpr size_t O_NAK = O_NAQ + AL((size_t)TT * 256 * 2);
constexpr size_t O_NAVT = O_NAK + AL((size_t)TT * 256 * 2);
constexpr size_t O_CQ = O_NAVT + AL((size_t)TT * 256 * 2);
constexpr size_t O_CKV = O_CQ + AL((size_t)TT * 384 * 2);
constexpr size_t O_UB = O_CKV + AL((size_t)TT * 256 * 2);
constexpr size_t O_QB = O_UB + AL((size_t)TT * 256 * 2);
constexpr size_t O_KN = O_QB + AL((size_t)TT * 768 * 2);
constexpr size_t O_KR = O_KN + AL((size_t)TT * 512 * 2);
constexpr size_t O_VT = O_KR + AL((size_t)TT * 32 * 2);
constexpr size_t O_PART = O_VT + AL((size_t)TT * 512 * 2);
constexpr size_t O_CNT = O_PART + AL((size_t)8 * TT * 4 * 4);
constexpr size_t O_END = O_CNT + AL((size_t)8 * 192 * 4);
constexpr size_t O_HID = O_X;
constexpr size_t O_CARRY = O_NAK;
constexpr size_t O_YSACT = O_NAVT;
static_assert(O_END <= (size_t)536870912, "workspace too large");
static_assert(O_HID + (size_t)TT * FH * 2 <= O_END, "hid does not fit");

struct Params { const float* in[34]; float* out; unsigned char* ws; };

DI unsigned pk2(float x, float y) { f2_t v = {x, y}; bf2_t b = __builtin_convertvector(v, bf2_t); return __builtin_bit_cast(unsigned, b); }
DI uint2 pk4(float a, float b, float c, float d) { uint2 r; r.x = pk2(a, b); r.y = pk2(c, d); return r; }
DI u16 bf1(float x) { return (u16)(pk2(x, 0.f) & 0xffffu); }
DI float bflo(unsigned v) { return __uint_as_float(v << 16); }
DI float bfhi(unsigned v) { return __uint_as_float(v & 0xffff0000u); }
DI int seq_of(int t) { return t < TP ? (t >> 12) : 8; }
DI int seq_len(int b) { return b < 8 ? 4096 : 16384; }
DI int pi32(int r) { return (r & 0x13) | ((r & 4) << 1) | ((r & 8) >> 1); }
DI float sigmoidf_(float x) { return __builtin_amdgcn_rcpf(1.f + __builtin_amdgcn_exp2f(-LOG2E * x)); }
DI float lane_xor(float v, int lane, int o) { return __int_as_float(__builtin_amdgcn_ds_bpermute((lane ^ o) << 2, __float_as_int(v))); }
DI float wave_sum(float v, int lane) {
#pragma unroll
  for (int o = 32; o >= 1; o >>= 1) v += lane_xor(v, lane, o);
  return v;
}
DI void zero_acc(f32x16& a) {
#pragma unroll
  for (int i = 0; i < 16; ++i) a[i] = 0.f;
}
DI bf16x8 ldg8(const u16* p) { return *(const bf16x8*)p; }
DI int otid(int wv) { int lane; asm volatile("v_mbcnt_lo_u32_b32 %0, -1, 0\n\tv_mbcnt_hi_u32_b32 %0, -1, %0" : "=v"(lane)); return wv * 64 + lane; }

struct ADesc { const u16* p0; long pitch0; const u16* p1; long pitch1; int ksplit; };
constexpr int LP = 72;

#define RAW_BARRIER() do { asm volatile("s_waitcnt lgkmcnt(0)" ::: "memory"); __builtin_amdgcn_s_barrier(); } while (0)
struct TileDesc { ADesc ad; const u16* bt; };

template <class DescFn, class EpiFn>
DI void gemm_stream(unsigned char* smem, const int wv, const int start, const int stride, const int end, const int ldb, const int nk, DescFn&& desc, EpiFn&& mkepi) {
  if (start >= end) return;
  const int tid = otid(wv), lane = tid & 63, wave = wv;
  const int wm = wave & 1, wn = wave >> 1;
  const int r32 = lane & 31, hh = lane >> 5;
  const bool isA = wave < 4;
  const int w3 = wave & 3;
  const int c0 = ((lane & 7) ^ (lane >> 4)) * 8, c1 = ((lane & 7) ^ (4 + (lane >> 4))) * 8;
  const int lrow = w3 * 64 + (lane >> 3);
  unsigned char* const ldst = smem + (isA ? 0 : 32768) + w3 * 8192;
#define DMA(td_, kt_, stage_)                                                                                    \
  {                                                                                                              \
    const int kt__ = (kt_);                                                                                      \
    const u16* src__; long pitch__;                                                                              \
    if (isA) {                                                                                                   \
      const bool first__ = kt__ < (td_).ad.ksplit;                                                               \
      src__ = (first__ ? (td_).ad.p0 : (td_).ad.p1) + (first__ ? kt__ : kt__ - (td_).ad.ksplit) * 64;            \
      pitch__ = first__ ? (td_).ad.pitch0 : (td_).ad.pitch1;                                                     \
    } else { src__ = (td_).bt + kt__ * 64; pitch__ = ldb; }                                                      \
    src__ += (long)lrow * pitch__;                                                                               \
    unsigned char* d__ = ldst + (stage_) * 65536;                                                                \
    _Pragma("unroll") for (int i = 0; i < 8; ++i)                                                                \
      __builtin_amdgcn_global_load_lds((const unsigned*)(src__ + (long)(i * 8) * pitch__ + ((i & 1) ? c1 : c0)), \
                                       (unsigned*)(d__ + i * 1024), 16, 0, 0);                                   \
  }
  const int sw = (r32 >> 1) & 7;
  const unsigned aoff = (unsigned)(wm * 128 + r32) * 128, boff = 32768u + (unsigned)(wn * 64 + r32) * 128;
#define LOADF(ks, S)                                                                                \
  {                                                                                                 \
    const unsigned co__ = (unsigned)((((ks) * 2 + hh) ^ sw) << 4);                                  \
    S##w0 = *(const bf16x8*)(sbase + boff + co__);                                                  \
    S##w1 = *(const bf16x8*)(sbase + boff + 32 * 128 + co__);                                       \
    S##t0 = *(const bf16x8*)(sbase + aoff + co__);                                                  \
    S##t1 = *(const bf16x8*)(sbase + aoff + 32 * 128 + co__);                                       \
    S##t2 = *(const bf16x8*)(sbase + aoff + 64 * 128 + co__);                                       \
    S##t3 = *(const bf16x8*)(sbase + aoff + 96 * 128 + co__);                                       \
  }
#define MMA(S)                                                                                      \
  {                                                                                                 \
    acc[0][0] = MFMA(S##w0, S##t0, acc[0][0]);                                                      \
    acc[1][0] = MFMA(S##w1, S##t0, acc[1][0]);                                                      \
    acc[0][1] = MFMA(S##w0, S##t1, acc[0][1]);                                                      \
    acc[1][1] = MFMA(S##w1, S##t1, acc[1][1]);                                                      \
    acc[0][2] = MFMA(S##w0, S##t2, acc[0][2]);                                                      \
    acc[1][2] = MFMA(S##w1, S##t2, acc[1][2]);                                                      \
    acc[0][3] = MFMA(S##w0, S##t3, acc[0][3]);                                                      \
    acc[1][3] = MFMA(S##w1, S##t3, acc[1][3]);                                                      \
  }
  int cur_i = start;
  TileDesc cur = desc(cur_i);
  DMA(cur, 0, 0);
#pragma unroll 1
  while (true) {
    const int nxt_i = cur_i + stride;
    const bool has_next = nxt_i < end;
    TileDesc nxt = cur;
    if (has_next) nxt = desc(nxt_i);
    f32x16 acc[2][4];
#pragma unroll
    for (int a = 0; a < 2; ++a)
#pragma unroll
      for (int b = 0; b < 4; ++b) zero_acc(acc[a][b]);
    bf16x8 Fw0, Fw1, Ft0, Ft1, Ft2, Ft3, Gw0, Gw1, Gt0, Gt1, Gt2, Gt3;
#pragma unroll 1
    for (int kt = 0; kt < nk; ++kt) {
      const int buf = kt & 1;
      asm volatile("s_waitcnt vmcnt(0)" ::: "memory");
      RAW_BARRIER();
      if (wave < 4) {
        if (kt + 1 < nk) { DMA(cur, kt + 1, buf ^ 1); }
        else if (has_next) { DMA(nxt, 0, 0); }
      }
      const unsigned char* sbase = smem + buf * 65536;
      LOADF(0, F);
      LOADF(1, G);
      MMA(F);
      if (wave >= 4) {
        if (kt + 1 < nk) { DMA(cur, kt + 1, buf ^ 1); }
        else if (has_next) { DMA(nxt, 0, 0); }
      }
      MMA(G);
      LOADF(2, F);
      LOADF(3, G);
      MMA(F);
      MMA(G);
    }
    mkepi(cur_i)(acc, wm, wn, lane);
    if (!has_next) break;
    cur = nxt;
    cur_i = nxt_i;
  }
  asm volatile("s_waitcnt vmcnt(0)" ::: "memory");
  RAW_BARRIER();
#undef LOADF
#undef MMA
#undef DMA
}

struct XcdOrder {
  int xcd, lb, nlb, mper, NG, total;
  DI XcdOrder(int MT, int NT, int NG_) { xcd = blockIdx.x & 7; lb = blockIdx.x >> 3; nlb = gridDim.x >> 3; mper = MT >> 3; NG = NG_; total = mper * NT; }
  DI void decode(int s, int& m, int& n) const {
    const int grp = s / (mper * NG), rem = s - grp * (mper * NG);
    m = xcd * mper + rem / NG; n = grp * NG + rem % NG;
  }
};

DI void rope_store(const f32x16& a, float rstd, const float* __restrict__ g, const float* __restrict__ ropel, float sc, u16* dst, int hh) {
#pragma unroll
  for (int q4 = 0; q4 < 2; ++q4) {
    const int j0 = 8 * q4 + 4 * hh;
    const float4 g1 = *(const float4*)(g + j0), g2 = *(const float4*)(g + 16 + j0);
    const float4 c = *(const float4*)(ropel + j0), s = *(const float4*)(ropel + 16 + j0);
    const float x1[4] = {a[q4 * 4 + 0] * rstd * g1.x, a[q4 * 4 + 1] * rstd * g1.y, a[q4 * 4 + 2] * rstd * g1.z, a[q4 * 4 + 3] * rstd * g1.w};
    const float x2[4] = {a[q4 * 4 + 8] * rstd * g2.x, a[q4 * 4 + 9] * rstd * g2.y, a[q4 * 4 + 10] * rstd * g2.z, a[q4 * 4 + 11] * rstd * g2.w};
    const float cc[4] = {c.x, c.y, c.z, c.w}, ss[4] = {s.x, s.y, s.z, s.w};
    float o1[4], o2[4];
#pragma unroll
    for (int j = 0; j < 4; ++j) { o1[j] = (x1[j] * cc[j] - x2[j] * ss[j]) * sc; o2[j] = (x1[j] * ss[j] + x2[j] * cc[j]) * sc; }
    *(uint2*)(dst + j0) = pk4(o1[0], o1[1], o1[2], o1[3]);
    *(uint2*)(dst + 16 + j0) = pk4(o2[0], o2[1], o2[2], o2[3]);
  }
}

DI float tile_ssq(const f32x16& a) {
  float s = 0.f;
#pragma unroll
  for (int i = 0; i < 16; ++i) s += a[i] * a[i];
  return s;
}

struct Ctx {
  const Params& P;
  unsigned char* smem;
  unsigned char* ws;
  int wv;
  DI float* mod() const { return (float*)(ws + O_MOD); }
  DI float* rope() const { return (float*)(ws + O_ROPE); }
  DI float* ssq() const { return (float*)(ws + O_SSQ); }
  DI float* sloc() const { return (float*)(ws + O_SLOC); }
  DI float* ktab() const { return (float*)(ws + O_KTAB); }
  DI float* part() const { return (float*)(ws + O_PART); }
  DI unsigned* cnt() const { return (unsigned*)(ws + O_CNT); }
  DI float2* etab() const { return (float2*)(ws + O_ETAB); }
  DI float2* bbar() const { return (float2*)(ws + O_BBAR); }
  DI u16* win() const { return (u16*)(ws + O_WIN); }
  DI u16* wuq() const { return (u16*)(ws + O_WUQ); }
  DI u16* wukv() const { return (u16*)(ws + O_WUKV); }
  DI u16* wglu() const { return (u16*)(ws + O_WGLU); }
  DI u16* wout() const { return (u16*)(ws + O_WOUT); }
  DI u16* wgu() const { return (u16*)(ws + O_WGU); }
  DI u16* wdn() const { return (u16*)(ws + O_WDN); }
  DI u16* kt() const { return (u16*)(ws + O_KT); }
  DI u16* mint() const { return (u16*)(ws + O_MINT); }
  DI u16* r1() const { return (u16*)(ws + O_R1); }
  DI u16* naq() const { return (u16*)(ws + O_NAQ); }
  DI u16* nak() const { return (u16*)(ws + O_NAK); }
  DI u16* navt() const { return (u16*)(ws + O_NAVT); }
  DI u16* cq() const { return (u16*)(ws + O_CQ); }
  DI u16* ckv() const { return (u16*)(ws + O_CKV); }
  DI u16* ub() const { return (u16*)(ws + O_UB); }
  DI u16* qb() const { return (u16*)(ws + O_QB); }
  DI u16* kn() const { return (u16*)(ws + O_KN); }
  DI u16* kr() const { return (u16*)(ws + O_KR); }
  DI u16* vt() const { return (u16*)(ws + O_VT); }
  DI u16* hid() const { return (u16*)(ws + O_HID); }
  DI u16* carry() const { return (u16*)(ws + O_CARRY); }
  DI u16* ysact() const { return (u16*)(ws + O_YSACT); }
};

__device__ const double INV_FREQ_TURNS[16] = {1.59154943091895346e-01, 8.94994016088910133e-02, 5.03292121044870353e-02, 2.83021958306233987e-02,
                                              1.59154943091895339e-02, 8.94994016088910237e-03, 5.03292121044870370e-03, 2.83021958306233987e-03,
                                              1.59154943091895356e-03, 8.94994016088910237e-04, 5.03292121044870326e-04, 2.83021958306233954e-04,
                                              1.59154943091895351e-04, 8.94994016088910182e-05, 5.03292121044870354e-05, 2.83021958306233961e-05};

DI void phase_init(const Ctx& c) {
  const Params& P = c.P;
  const int tid = otid(c.wv);
  if (blockIdx.x == 0) for (int i = tid; i < 8 * 192; i += NTH) c.cnt()[i] = 0u;
  for (int it = blockIdx.x; it < 640; it += gridDim.x) {
    __syncthreads();
    if (it < 384) {
      const int l = it / 96, n0 = (it % 96) * 64;
      float* sc = (float*)c.smem;
      float* red = sc + 9 * 1024;
      for (int i = tid; i < 9 * 1024; i += NTH) {
        const int b = i >> 10, k = i & 1023;
        const float v = b < 8 ? P.in[2][b * 1024 + k] : P.in[3][k];
        sc[i] = v / (1.f + __expf(-v));
      }
      __syncthreads();
      const int col = tid & 63, kq = tid >> 6;
      float acc[9];
#pragma unroll
      for (int b = 0; b < 9; ++b) acc[b] = 0.f;
      const float* w = P.in[4] + (size_t)l * 1024 * 6144 + n0 + col;
      for (int k = kq * 128; k < kq * 128 + 128; ++k) {
        const float wv = w[(size_t)k * 6144];
#pragma unroll
        for (int b = 0; b < 9; ++b) acc[b] += sc[b * 1024 + k] * wv;
      }
#pragma unroll
      for (int b = 0; b < 9; ++b) red[(kq * 9 + b) * 64 + col] = acc[b];
      __syncthreads();
      for (int i = tid; i < 9 * 64; i += NTH) {
        const int b = i >> 6, cc = i & 63;
        float v = 0.f;
#pragma unroll
        for (int q = 0; q < 8; ++q) v += red[(q * 9 + b) * 64 + cc];
        c.mod()[(size_t)(l * 9 + b) * 6144 + n0 + cc] = v + P.in[5][l * 6144 + n0 + cc];
      }
    } else if (it < 512) {
      const int base = (it - 384) * 2048;
      for (int i = tid; i < 2048; i += NTH) {
        const int idx = base + i, pos = idx >> 4, j = idx & 15;
        double t = (double)pos * INV_FREQ_TURNS[j];
        t -= __builtin_rint(t);
        const float tf = (float)t;
        c.rope()[pos * 32 + j] = __builtin_amdgcn_cosf(tf);
        c.rope()[pos * 32 + 16 + j] = __builtin_amdgcn_sinf(tf);
      }
    } else {
      const int id = it - 512, l = id >> 5, g = (id >> 1) & 15, dir = id & 1;
      float* Ere = (float*)c.smem;
      float* Eim = Ere + 64 * 33;
      float* Bre = Eim + 64 * 33;
      float* Bim = Bre + 64 * 16;
      const int ag = (l * 2 + dir) * 16 + g;
      const float dt = __expf(P.in[25][ag]);
      for (int i = tid; i < 64 * 33; i += NTH) {
        const int p = i / 33, d = i - p * 33;
        const float are = P.in[19][ag * 64 + p], aim = P.in[20][ag * 64 + p];
        const float mag = __expf(are * dt * (float)d);
        double t = (double)aim * (double)dt * (double)d * 0.15915494309189535;
        t -= __builtin_rint(t);
        const float tf = (float)t;
        const float er = mag * __builtin_amdgcn_cosf(tf), ei = mag * __builtin_amdgcn_sinf(tf);
        Ere[i] = er; Eim[i] = ei;
        c.etab()[(size_t)((l * 16 + g) * 2 + dir) * 64 * 33 + i] = make_float2(er, ei);
      }
      for (int i = tid; i < 64 * 16; i += NTH) {
        const int p = i >> 4, cc = i & 15;
        const float are = P.in[19][ag * 64 + p], aim = P.in[20][ag * 64 + p];
        const float xr = are * dt;
        double t = (double)aim * (double)dt * 0.15915494309189535;
        t -= __builtin_rint(t);
        const float tf = (float)t;
        const float cs = __builtin_amdgcn_cosf(tf), sn = __builtin_amdgcn_sinf(tf), sh = __builtin_amdgcn_sinf(0.5f * tf);
        const float em1 = expm1f(xr);
        const float nr = em1 * cs - 2.f * sh * sh, ni = (em1 + 1.f) * sn;
        const float den = 1.f / (are * are + aim * aim);
        const float qr = (nr * are + ni * aim) * den, qi = (ni * are - nr * aim) * den;
        const float br = P.in[21][(size_t)(ag * 64 + p) * 16 + cc], bi = P.in[22][(size_t)(ag * 64 + p) * 16 + cc];
        const float rr = qr * br - qi * bi, ri = qr * bi + qi * br;
        Bre[i] = rr; Bim[i] = ri;
        c.bbar()[(size_t)(((l * 16 + g) * 2 + dir) * 64) * 16 + i] = make_float2(rr, ri);
      }
      __syncthreads();
      {
        const int pr_ = tid & 255, dh = tid >> 8;
        const int co = pr_ >> 4, ci = pr_ & 15;
        float acc[16];
#pragma unroll
        for (int d = 0; d < 16; ++d) acc[d] = 0.f;
        const float* cre = P.in[23] + (size_t)(ag * 16 + co) * 64;
        const float* cim = P.in[24] + (size_t)(ag * 16 + co) * 64;
        for (int p = 0; p < 64; ++p) {
          const float cr = cre[p], cim_ = cim[p];
          const float br = Bre[p * 16 + ci], bi = Bim[p * 16 + ci];
          const float gr = cr * br - cim_ * bi, gi = cr * bi + cim_ * br;
#pragma unroll
          for (int d = 0; d < 16; ++d) acc[d] += gr * Ere[p * 33 + dh * 16 + d] - gi * Eim[p * 33 + dh * 16 + d];
        }
#pragma unroll
        for (int d = 0; d < 16; ++d) c.ktab()[((size_t)(((l * 16 + g) * 2 + dir) * 32 + dh * 16 + d)) * 256 + pr_] = acc[d];
      }
    }
  }
}

DI int perm_col(int kind, int n) {
  switch (kind) {
    case 0: return n < 1408 ? n : (n < 1440 ? n - 1408 + 1664 : n - 1440 + 1408);
    case 1: { const int h = n / 96, j = n - h * 96; return j < 64 ? h * 64 + j : 512 + h * 32 + (j - 64); }
    case 2: { const int h = n >> 7, j = n & 127; return j < 64 ? h * 64 + j : 512 + h * 64 + (j - 64); }
    case 5: return (n >> 5) * 64 + (n & 31);
    case 6: return (n >> 5) * 64 + 32 + (n & 31);
    default: return n;
  }
}

DI void conv_tile(unsigned char* smem, const int wv, const float* __restrict__ src, u16* __restrict__ dst, int K, int N, int kind, const float* __restrict__ gain, int ktile, int ntile, bool kperm = false) {
  u16(*T)[LP] = (u16(*)[LP])smem;
  const int tid = otid(wv);
  const int nl = tid & 63, kq = tid >> 6;
  const int n = ntile * 64 + nl, k0 = ktile * 64;
  __syncthreads();
#pragma unroll 4
  for (int i = 0; i < 8; ++i) {
    const int k = kq * 8 + i;
    float v = 0.f;
    if (n < N) { v = src[(size_t)(k0 + k) * N + n]; if (gain) v *= gain[k0 + k]; }
    T[nl][k] = bf1(v);
  }
  __syncthreads();
  const int row = tid >> 3, seg = tid & 7;
  const int nn = ntile * 64 + row;
  if (nn < N) {
    const int dr = perm_col(kind, nn);
    uint4 v0;
    if (kperm) {
      const int base = (seg >> 2) * 32 + (seg & 1) * 16 + ((seg >> 1) & 1) * 4;
      const uint2 lo = *(const uint2*)&T[row][base], hi = *(const uint2*)&T[row][base + 8];
      v0 = make_uint4(lo.x, lo.y, hi.x, hi.y);
    } else {
      v0 = *(const uint4*)&T[row][seg * 8];
    }
    *(uint4*)(dst + (size_t)dr * K + k0 + seg * 8) = v0;
  }
}

DI void norm_rows(const Ctx& c, int layer, int which) {
  const Params& P = c.P;
  const int tid_ = otid(c.wv);
  const int lane = tid_ & 63, wave = tid_ >> 6;
  const float* g = P.in[which ? 30 : 6] + layer * 1024;
  for (int tok0 = (blockIdx.x * 8 + wave) * 2; tok0 < TT; tok0 += gridDim.x * 16) {
    float4 v[2][4];
    float ss[2] = {0.f, 0.f};
#pragma unroll
    for (int t = 0; t < 2; ++t) {
      const int tok = tok0 + t;
      const float* x;
      if (layer == 0 && which == 0) x = tok < TP ? P.in[0] + (size_t)tok * 1024 : P.in[1] + (size_t)(tok - TP) * 1024;
      else x = P.out + (size_t)tok * 1024;
#pragma unroll
      for (int j = 0; j < 4; ++j) v[t][j] = *(const float4*)(x + j * 256 + lane * 4);
    }
#pragma unroll
    for (int t = 0; t < 2; ++t) {
#pragma unroll
      for (int j = 0; j < 4; ++j) ss[t] += v[t][j].x * v[t][j].x + v[t][j].y * v[t][j].y + v[t][j].z * v[t][j].z + v[t][j].w * v[t][j].w;
      ss[t] = wave_sum(ss[t], lane);
    }
    const int b = seq_of(tok0);
    const float* md = c.mod() + (size_t)(layer * 9 + b) * 6144 + (which ? 3072 : 0);
#pragma unroll
    for (int j = 0; j < 4; ++j) {
      const int idx = j * 256 + lane * 4;
      const float4 gg = *(const float4*)(g + idx), sh = *(const float4*)(md + idx), scl = *(const float4*)(md + 1024 + idx);
#pragma unroll
      for (int t = 0; t < 2; ++t) {
        const float rstd = rsqrtf(ss[t] * (1.f / 1024.f) + RMS_EPS);
        const float o0 = v[t][j].x * rstd * gg.x * (1.f + scl.x) + sh.x;
        const float o1 = v[t][j].y * rstd * gg.y * (1.f + scl.y) + sh.y;
        const float o2 = v[t][j].z * rstd * gg.z * (1.f + scl.z) + sh.z;
        const float o3 = v[t][j].w * rstd * gg.w * (1.f + scl.w) + sh.w;
        *(uint2*)(c.r1() + (size_t)(tok0 + t) * 1024 + ((idx & ~31) + ((idx >> 2) & 1) * 16 + ((idx >> 3) & 3) * 4)) = pk4(o0, o1, o2, o3);
      }
    }
  }
}

constexpr int PREP_NA = 825, PREP_NB = 784, PREP_NC = 2112;
DI void prep_items(const Ctx& c, int l, int group, int start, int stride) {
  const Params& P = c.P;
  const int tid = otid(c.wv);
  constexpr int C0 = 432, C1 = C0 + 72, C2 = C1 + 64, C3 = C2 + 16, C4 = C3 + 256, C5 = C4 + 704, C6 = C5 + 704, C7 = C6 + 704;
  constexpr int CZ = C7 + 1, CK = CZ + 512, CM = CK + 256;
  static_assert(C2 + 1 + (CM - CK) == PREP_NA && (C4 - C2) + (CK - CZ) == PREP_NB && (C7 - C4) == PREP_NC, "prep item counts");
  const int nitems = group == 0 ? PREP_NA : (group == 1 ? PREP_NB : PREP_NC);
  for (int gi = start; gi < nitems; gi += stride) {
    int it;
    if (group == 0) it = gi < C2 ? gi : (gi == C2 ? C7 : CK + (gi - C2 - 1));
    else if (group == 1) it = gi < (C4 - C2) ? C2 + gi : CZ + (gi - (C4 - C2));
    else it = C4 + gi;
    if (it < C0) conv_tile(c.smem, c.wv, P.in[7] + (size_t)l * 1024 * 1696, c.win(), 1024, 1696, 0, nullptr, it / 27, it % 27, true);
    else if (it < C1) { const int j = it - C0; conv_tile(c.smem, c.wv, P.in[13] + (size_t)l * 384 * 768, c.wuq(), 384, 768, 1, P.in[11] + l * 384, j / 12, j % 12, true); }
    else if (it < C2) { const int j = it - C1; conv_tile(c.smem, c.wv, P.in[14] + (size_t)l * 256 * 1024, c.wukv(), 256, 1024, 2, P.in[12] + l * 256, j / 16, j % 16, true); }
    else if (it < C3) { const int j = it - C2; conv_tile(c.smem, c.wv, P.in[27] + (size_t)l * 256 * 256, c.wglu(), 256, 256, 3, nullptr, j / 4, j % 4); }
    else if (it < C4) { const int j = it - C3; conv_tile(c.smem, c.wv, P.in[29] + (size_t)l * 1024 * 1024, c.wout(), 1024, 1024, 3, nullptr, j / 16, j % 16); }
    else if (it < C5) { const int j = it - C4; conv_tile(c.smem, c.wv, P.in[31] + (size_t)l * 1024 * FH, c.wgu(), 1024, FH, 5, nullptr, j / 44, j % 44, true); }
    else if (it < C6) { const int j = it - C5; conv_tile(c.smem, c.wv, P.in[32] + (size_t)l * 1024 * FH, c.wgu(), 1024, FH, 6, nullptr, j / 44, j % 44, true); }
    else if (it < C7) { const int j = it - C6; conv_tile(c.smem, c.wv, P.in[33] + (size_t)l * FH * 1024, c.wdn(), FH, 1024, 3, nullptr, j / 16, j % 16, true); }
    else if (it < CZ) {
      uint4 z = make_uint4(0, 0, 0, 0);
      asm volatile("" : "+v"(z.x), "+v"(z.y), "+v"(z.z), "+v"(z.w));
      uint4* d = (uint4*)(c.win() + (size_t)1696 * 1024);
      for (int i = tid; i < 96 * 1024 / 8; i += NTH) d[i] = z;
    } else if (it < CK) {
      const int j = it - CZ, g = j >> 5, t = j & 31;
      const float* ktf = c.ktab() + (size_t)((l * 16 + g) * 2 + 0) * 32 * 256;
      const float* ktb = c.ktab() + (size_t)((l * 16 + g) * 2 + 1) * 32 * 256;
      unsigned res[12];
#pragma unroll
      for (int q = 0; q < 12; ++q) {
        const int e = tid + q * NTH;
        const int cc = e / 384, k2 = (e - cc * 384) * 2;
        float v[2];
#pragma unroll
        for (int u = 0; u < 2; ++u) {
          const int k = k2 + u;
          float val;
          if (k < 512) {
            const int s = k >> 4, ci = k & 15;
            val = 0.f;
            if (s <= t) val += ktf[(t - s) * 256 + cc * 16 + ci];
            if (s >= t) val += ktb[(s - t) * 256 + cc * 16 + ci];
            if (s == t && ci == cc) val += P.in[26][l * 256 + g * 16 + cc];
          } else {
            const int kk = k - 512, dir = kk >> 7, p = (kk & 127) >> 1, ri = kk & 1;
            const int ex = dir == 0 ? t + 1 : 32 - t;
            const float2 E = c.etab()[((size_t)((l * 16 + g) * 2 + dir) * 64 + p) * 33 + ex];
            const size_t ci_ = ((size_t)((l * 2 + dir) * 16 + g) * 16 + cc) * 64 + p;
            const float cr = P.in[23][ci_], cim = P.in[24][ci_];
            val = ri == 0 ? (cr * E.x - cim * E.y) : -(cr * E.y + cim * E.x);
          }
          v[u] = val;
        }
        res[q] = pk2(v[0], v[1]);
      }
#pragma unroll
      for (int q = 0; q < 12; ++q) {
        const int e = tid + q * NTH;
        const int cc = e / 384, k2 = (e - cc * 384) * 2;
        *(unsigned*)(c.kt() + ((size_t)g * 512 + t * 16 + cc) * 768 + k2) = res[q];
      }
    } else {
      const int j = it - CK, g = j >> 4, nb = (j & 15) * 16;
      unsigned res[8];
#pragma unroll
      for (int q = 0; q < 8; ++q) {
        const int e = tid + q * NTH;
        const int rr = e >> 8, k2 = (e & 255) * 2;
        const int n = nb + rr, dir = n >> 7, p = (n & 127) >> 1, ri = n & 1;
        const int s = k2 >> 4, ci = k2 & 15;
        const int ex = dir == 0 ? 31 - s : s;
        const float2 E = c.etab()[((size_t)((l * 16 + g) * 2 + dir) * 64 + p) * 33 + ex];
        const float2 b0 = c.bbar()[((size_t)((l * 16 + g) * 2 + dir) * 64 + p) * 16 + ci];
        const float2 b1 = c.bbar()[((size_t)((l * 16 + g) * 2 + dir) * 64 + p) * 16 + ci + 1];
        const float v0 = ri == 0 ? (E.x * b0.x - E.y * b0.y) : (E.x * b0.y + E.y * b0.x);
        const float v1 = ri == 0 ? (E.x * b1.x - E.y * b1.y) : (E.x * b1.y + E.y * b1.x);
        res[q] = pk2(v0, v1);
      }
#pragma unroll
      for (int q = 0; q < 8; ++q) {
        const int e = tid + q * NTH;
        const int rr = e >> 8, k2 = (e & 255) * 2;
        *(unsigned*)(c.mint() + ((size_t)g * 256 + nb + rr) * 512 + k2) = res[q];
      }
    }
  }
}

DI int tail_slot(int total_tiles, int& stride) {
  const int lb = blockIdx.x >> 3, nlb = gridDim.x >> 3, xcd = blockIdx.x & 7;
  const int rem = total_tiles % nlb;
  if (rem == 0) { stride = (int)gridDim.x; return (int)blockIdx.x; }
  stride = 8 * (nlb - rem);
  return lb < rem ? (1 << 30) : xcd * (nlb - rem) + (lb - rem);
}

struct EpiG1 {
  const Ctx& c; int layer, m0, n0;
  DI void operator()(f32x16 (&acc)[2][4], int wm, int wn, int lane) const {
    const Params& P = c.P;
    const int r32 = lane & 31, hh = lane >> 5;
    const int nb = n0 + wn * 64, mb = m0 + wm * 128;
    const int b = seq_of(mb), Lb = seq_len(b), s0 = b * 4096;
    if (nb < 512) {
      const bool isq = nb < 256;
      const float* g = P.in[isq ? 8 : 9] + layer * 64;
      u16* dst = isq ? c.naq() : c.nak();
      const int cb = nb & 255;
      const float sc = isq ? QS_NA : 1.f;
#pragma unroll
      for (int mt = 0; mt < 4; ++mt) {
        float ss = tile_ssq(acc[0][mt]) + tile_ssq(acc[1][mt]);
        ss += lane_xor(ss, lane, 32);
        const float rstd = rsqrtf(ss * (1.f / 64.f) + RMS_EPS) * sc;
        const int tok = mb + mt * 32 + r32;
#pragma unroll
        for (int nt = 0; nt < 2; ++nt) {
          uint2 pk[4];
#pragma unroll
          for (int q4 = 0; q4 < 4; ++q4) {
            const float4 gg = *(const float4*)(g + nt * 32 + q4 * 8 + hh * 4);
            pk[q4] = pk4(acc[nt][mt][q4 * 4 + 0] * rstd * gg.x, acc[nt][mt][q4 * 4 + 1] * rstd * gg.y, acc[nt][mt][q4 * 4 + 2] * rstd * gg.z, acc[nt][mt][q4 * 4 + 3] * rstd * gg.w);
          }
          u16* d_ = dst + (size_t)tok * 256 + cb + nt * 32 + hh * 16;
          *(uint4*)d_ = make_uint4(pk[0].x, pk[0].y, pk[1].x, pk[1].y);
          *(uint4*)(d_ + 8) = make_uint4(pk[2].x, pk[2].y, pk[3].x, pk[3].y);
        }
      }
    } else if (nb < 768) {
      const int head = (nb - 512) >> 6;
#pragma unroll
      for (int mt = 0; mt < 4; ++mt) {
        const int l = mb + mt * 32 + r32 - s0;
#pragma unroll
        for (int nt = 0; nt < 2; ++nt)
#pragma unroll
          for (int i = 0; i < 16; ++i) {
            const int d = nt * 32 + (i & 3) + 8 * (i >> 2) + 4 * hh;
            c.navt()[(size_t)s0 * 256 + (size_t)(head * 64 + d) * Lb + l] = bf1(acc[nt][mt][i]);
          }
      }
    } else if (nb < 1408) {
      const bool isq = nb < 1152;
      const int cb = isq ? nb - 768 : nb - 1152;
      const int pitch = isq ? 384 : 256;
      u16* dst = isq ? c.cq() : c.ckv();
      const int slot = isq ? (cb >> 6) : 6 + (cb >> 6);
#pragma unroll
      for (int mt = 0; mt < 4; ++mt) {
        float ss = tile_ssq(acc[0][mt]) + tile_ssq(acc[1][mt]);
        ss += lane_xor(ss, lane, 32);
        const int tok = mb + mt * 32 + r32;
        if (hh == 0) c.ssq()[(size_t)tok * 16 + slot] = ss;
#pragma unroll
        for (int nt = 0; nt < 2; ++nt) {
          u16* d_ = dst + (size_t)tok * pitch + cb + nt * 32 + hh * 16;
          *(uint4*)d_ = make_uint4(pk2(acc[nt][mt][0], acc[nt][mt][1]), pk2(acc[nt][mt][2], acc[nt][mt][3]), pk2(acc[nt][mt][4], acc[nt][mt][5]), pk2(acc[nt][mt][6], acc[nt][mt][7]));
          *(uint4*)(d_ + 8) = make_uint4(pk2(acc[nt][mt][8], acc[nt][mt][9]), pk2(acc[nt][mt][10], acc[nt][mt][11]), pk2(acc[nt][mt][12], acc[nt][mt][13]), pk2(acc[nt][mt][14], acc[nt][mt][15]));
        }
      }
    } else if (nb < 1664) {
      const int cb = nb - 1408;
#pragma unroll
      for (int mt = 0; mt < 4; ++mt) {
        const int l = mb + mt * 32 + r32 - s0;
#pragma unroll
        for (int nt = 0; nt < 2; ++nt)
#pragma unroll
          for (int q4 = 0; q4 < 4; ++q4) {
            const int col = cb + nt * 32 + q4 * 8 + hh * 4;
            const int g = col >> 4, cc = col & 15;
            *(uint2*)(c.ub() + ((size_t)g * 1536 + ((s0 + l) >> 5)) * 512 + ((s0 + l) & 31) * 16 + cc) = pk4(acc[nt][mt][q4 * 4 + 0], acc[nt][mt][q4 * 4 + 1], acc[nt][mt][q4 * 4 + 2], acc[nt][mt][q4 * 4 + 3]);
          }
      }
    } else if (nb == 1664) {
      const float* g = P.in[18] + layer * 32;
#pragma unroll
      for (int mt = 0; mt < 4; ++mt) {
        float ss = tile_ssq(acc[0][mt]);
        ss += lane_xor(ss, lane, 32);
        const float rstd = rsqrtf(ss * (1.f / 32.f) + RMS_EPS);
        const int tok = mb + mt * 32 + r32, l = tok - s0;
        rope_store(acc[0][mt], rstd, g, c.rope() + (size_t)l * 32, 1.f, c.kr() + (size_t)tok * 32, hh);
      }
    }
  }
};

struct EpiQ {
  const Ctx& c; int layer, m0, n0;
  DI void operator()(f32x16 (&acc)[2][4], int wm, int wn, int lane) const {
    const Params& P = c.P;
    const int r32 = lane & 31, hh = lane >> 5;
    const int nb = n0 + wn * 64, mb = m0 + wm * 128;
    const int b = seq_of(mb), Lb = seq_len(b), s0 = b * 4096;
#pragma unroll
    for (int mt = 0; mt < 4; ++mt) {
      const int tok = mb + mt * 32 + r32, l = tok - s0;
      const float* sq = c.ssq() + (size_t)tok * 16;
      const float4 s4 = *(const float4*)sq;
      const float2 s2 = *(const float2*)(sq + 4);
      const float rc = rsqrtf((s4.x + s4.y + s4.z + s4.w + s2.x + s2.y) * (1.f / 384.f) + RMS_EPS);
      if (nb < 512) {
        const int head = nb >> 6;
        const float* g = P.in[15] + layer * 64;
        float ss = (tile_ssq(acc[0][mt]) + tile_ssq(acc[1][mt])) * rc * rc;
        ss += lane_xor(ss, lane, 32);
        const float rstd = rsqrtf(ss * (1.f / 64.f) + RMS_EPS) * rc * QS_MLA;
        u16* dst = c.qb() + (size_t)s0 * 768 + ((size_t)head * Lb + l) * 96;
#pragma unroll
        for (int nt = 0; nt < 2; ++nt) {
          uint2 pk[4];
#pragma unroll
          for (int q4 = 0; q4 < 4; ++q4) {
            const float4 gg = *(const float4*)(g + nt * 32 + q4 * 8 + hh * 4);
            pk[q4] = pk4(acc[nt][mt][q4 * 4 + 0] * rstd * gg.x, acc[nt][mt][q4 * 4 + 1] * rstd * gg.y, acc[nt][mt][q4 * 4 + 2] * rstd * gg.z, acc[nt][mt][q4 * 4 + 3] * rstd * gg.w);
          }
          u16* d_ = dst + nt * 32 + hh * 16;
          *(uint4*)d_ = make_uint4(pk[0].x, pk[0].y, pk[1].x, pk[1].y);
          *(uint4*)(d_ + 8) = make_uint4(pk[2].x, pk[2].y, pk[3].x, pk[3].y);
        }
      } else {
        const float* g = P.in[17] + layer * 32;
#pragma unroll
        for (int nt = 0; nt < 2; ++nt) {
          const int head = ((nb - 512) >> 5) + nt;
          float ss = tile_ssq(acc[nt][mt]) * rc * rc;
          ss += lane_xor(ss, lane, 32);
          const float rstd = rsqrtf(ss * (1.f / 32.f) + RMS_EPS) * rc;
          rope_store(acc[nt][mt], rstd, g, c.rope() + (size_t)l * 32, QS_MLA, c.qb() + (size_t)s0 * 768 + ((size_t)head * Lb + l) * 96 + 64, hh);
        }
      }
    }
  }
};

struct EpiKV {
  const Ctx& c; int layer, m0, n0;
  DI void operator()(f32x16 (&acc)[2][4], int wm, int wn, int lane) const {
    const Params& P = c.P;
    const int r32 = lane & 31, hh = lane >> 5;
    const int nb = n0 + wn * 64, mb = m0 + wm * 128;
    const int b = seq_of(mb), Lb = seq_len(b), s0 = b * 4096;
#pragma unroll
    for (int mt = 0; mt < 4; ++mt) {
      const int tok = mb + mt * 32 + r32, l = tok - s0;
      const float4 s4 = *(const float4*)(c.ssq() + (size_t)tok * 16 + 4);
      const float4 s5 = *(const float4*)(c.ssq() + (size_t)tok * 16 + 8);
      const float rc = rsqrtf((s4.z + s4.w + s5.x + s5.y) * (1.f / 256.f) + RMS_EPS);
      if (nb < 512) {
        const int head = nb >> 6;
        const float* g = P.in[16] + layer * 64;
        float ss = (tile_ssq(acc[0][mt]) + tile_ssq(acc[1][mt])) * rc * rc;
        ss += lane_xor(ss, lane, 32);
        const float rstd = rsqrtf(ss * (1.f / 64.f) + RMS_EPS) * rc;
        u16* dst = c.kn() + (size_t)s0 * 512 + ((size_t)head * Lb + l) * 64;
#pragma unroll
        for (int nt = 0; nt < 2; ++nt) {
          uint2 pk[4];
#pragma unroll
          for (int q4 = 0; q4 < 4; ++q4) {
            const float4 gg = *(const float4*)(g + nt * 32 + q4 * 8 + hh * 4);
            pk[q4] = pk4(acc[nt][mt][q4 * 4 + 0] * rstd * gg.x, acc[nt][mt][q4 * 4 + 1] * rstd * gg.y, acc[nt][mt][q4 * 4 + 2] * rstd * gg.z, acc[nt][mt][q4 * 4 + 3] * rstd * gg.w);
          }
          u16* d_ = dst + nt * 32 + hh * 16;
          *(uint4*)d_ = make_uint4(pk[0].x, pk[0].y, pk[1].x, pk[1].y);
          *(uint4*)(d_ + 8) = make_uint4(pk[2].x, pk[2].y, pk[3].x, pk[3].y);
        }
      } else {
        const int head = (nb - 512) >> 6;
#pragma unroll
        for (int nt = 0; nt < 2; ++nt)
#pragma unroll
          for (int i = 0; i < 16; ++i) {
            const int d = nt * 32 + (i & 3) + 8 * (i >> 2) + 4 * hh;
            c.vt()[(size_t)s0 * 512 + (size_t)(head * 64 + d) * Lb + l] = bf1(acc[nt][mt][i] * rc);
          }
      }
    }
  }
};

struct EpiSloc {
  const Ctx& c; int gc0, g, n0;
  DI void operator()(f32x16 (&acc)[2][4], int wm, int wn, int lane) const {
    const int r32 = lane & 31, hh = lane >> 5;
#pragma unroll
    for (int mt = 0; mt < 4; ++mt) {
      const int chunk = gc0 + wm * 128 + mt * 32 + r32;
      float* dst = c.sloc() + ((size_t)chunk * 16 + g) * 256 + n0 + wn * 64;
#pragma unroll
      for (int nt = 0; nt < 2; ++nt)
#pragma unroll
        for (int q4 = 0; q4 < 4; ++q4)
          *(float4*)(dst + nt * 32 + q4 * 8 + hh * 4) = make_float4(acc[nt][mt][q4 * 4 + 0], acc[nt][mt][q4 * 4 + 1], acc[nt][mt][q4 * 4 + 2], acc[nt][mt][q4 * 4 + 3]);
    }
  }
};

DI float gelu_tanh(float x) {
  const float u = 0.7978845608028654f * (x + 0.044715f * x * x * x);
  const float e = __builtin_amdgcn_exp2f(2.f * LOG2E * u);
  const float th = 1.f - 2.f * __builtin_amdgcn_rcpf(e + 1.f);
  return 0.5f * x * (1.f + th);
}

struct EpiYs {
  const Ctx& c; int gc0, g, n0;
  DI void operator()(f32x16 (&acc)[2][4], int wm, int wn, int lane) const {
    const int r32 = lane & 31, hh = lane >> 5;
#pragma unroll
    for (int mt = 0; mt < 4; ++mt) {
      const int chunk = gc0 + wm * 128 + mt * 32 + r32;
#pragma unroll
      for (int nt = 0; nt < 2; ++nt)
#pragma unroll
        for (int q4 = 0; q4 < 4; ++q4) {
          const int n = n0 + wn * 64 + nt * 32 + q4 * 8 + hh * 4;
          const int t = n >> 4, cc = n & 15;
          *(uint2*)(c.ysact() + ((size_t)chunk * 32 + t) * 256 + g * 16 + cc) =
              pk4(gelu_tanh(acc[nt][mt][q4 * 4 + 0]), gelu_tanh(acc[nt][mt][q4 * 4 + 1]), gelu_tanh(acc[nt][mt][q4 * 4 + 2]), gelu_tanh(acc[nt][mt][q4 * 4 + 3]));
        }
    }
  }
};

struct EpiGlu {
  const Ctx& c; int layer, m0, n0;
  DI void operator()(f32x16 (&acc)[2][4], int wm, int wn, int lane) const {
    const int r32 = lane & 31, hh = lane >> 5;
    const float* gb = c.P.in[28] + layer * 256;
#pragma unroll
    for (int mt = 0; mt < 4; ++mt) {
      const int tok = m0 + wm * 128 + mt * 32 + r32;
#pragma unroll
      for (int nt = 0; nt < 2; ++nt)
#pragma unroll
        for (int q4 = 0; q4 < 4; ++q4) {
          const int n = n0 + wn * 64 + nt * 32 + q4 * 8 + hh * 4;
          const float4 bb = *(const float4*)(gb + n);
          const uint2 ys = *(const uint2*)(c.ysact() + (size_t)tok * 256 + n);
          *(uint2*)(c.r1() + (size_t)tok * 1024 + 768 + n) =
              pk4(bflo(ys.x) * sigmoidf_(acc[nt][mt][q4 * 4 + 0] + bb.x), bfhi(ys.x) * sigmoidf_(acc[nt][mt][q4 * 4 + 1] + bb.y),
                  bflo(ys.y) * sigmoidf_(acc[nt][mt][q4 * 4 + 2] + bb.z), bfhi(ys.y) * sigmoidf_(acc[nt][mt][q4 * 4 + 3] + bb.w));
        }
    }
  }
};

struct EpiRes {
  const Ctx& c; int layer, m0, n0, gidx; bool from_input; int inst, ngi, nlayer, moff;
  DI void operator()(f32x16 (&acc)[2][4], int wm, int wn, int lane) const {
    const Params& P = c.P;
    const int r32 = lane & 31, hh = lane >> 5;
    const int mb = m0 + wm * 128;
    const int b = seq_of(mb);
    const float* gate = c.mod() + (size_t)(layer * 9 + b) * 6144 + gidx * 1024;
#pragma unroll
    for (int mt = 0; mt < 4; ++mt) {
      const int tok = mb + mt * 32 + r32;
      const float* xin = from_input ? (tok < TP ? P.in[0] + (size_t)tok * 1024 : P.in[1] + (size_t)(tok - TP) * 1024) : P.out + (size_t)tok * 1024;
      float* xo = P.out + (size_t)tok * 1024;
#pragma unroll
      for (int nt = 0; nt < 2; ++nt)
#pragma unroll
        for (int q4 = 0; q4 < 4; ++q4) {
          const int n = n0 + wn * 64 + nt * 32 + q4 * 8 + hh * 4;
          const float4 gg = *(const float4*)(gate + n);
          const float4 xv = *(const float4*)(xin + n);
          const float4 xn = make_float4(xv.x + gg.x * acc[nt][mt][q4 * 4 + 0], xv.y + gg.y * acc[nt][mt][q4 * 4 + 1], xv.z + gg.z * acc[nt][mt][q4 * 4 + 2], xv.w + gg.w * acc[nt][mt][q4 * 4 + 3]);
          if (inst < 0) *(float4*)(xo + n) = xn;
          acc[nt][mt][q4 * 4 + 0] = xn.x; acc[nt][mt][q4 * 4 + 1] = xn.y; acc[nt][mt][q4 * 4 + 2] = xn.z; acc[nt][mt][q4 * 4 + 3] = xn.w;
        }
    }
    if (inst < 0) return;
    float* red = (float*)(c.smem + 131072);
#pragma unroll
    for (int mt = 0; mt < 4; ++mt) {
      float ss = tile_ssq(acc[0][mt]) + tile_ssq(acc[1][mt]);
      ss += lane_xor(ss, lane, 32);
      if (hh == 0) red[(wm * 128 + mt * 32 + r32) * 4 + wn] = ss;
    }
    __syncthreads();
    const int tid = c.wv * 64 + lane;
    float* part = c.part() + (size_t)inst * TT * 4;
    unsigned* cnt = c.cnt() + inst * 192 + (m0 >> 8);
    if (tid < 256) {
      const float4 r = *(const float4*)(red + tid * 4);
      __hip_atomic_store(part + (size_t)(m0 + tid) * 4 + (n0 >> 8), r.x + r.y + r.z + r.w, __ATOMIC_RELAXED, __HIP_MEMORY_SCOPE_AGENT);
    }
    asm volatile("s_waitcnt vmcnt(0)" ::: "memory");
    __syncthreads();
    if (tid == 0) __hip_atomic_fetch_add(cnt, 1u, __ATOMIC_RELAXED, __HIP_MEMORY_SCOPE_AGENT);
#pragma unroll
    for (int mt = 0; mt < 4; ++mt) {
      float* xo = P.out + (size_t)(mb + mt * 32 + r32) * 1024;
#pragma unroll
      for (int nt = 0; nt < 2; ++nt)
#pragma unroll
        for (int q4 = 0; q4 < 4; ++q4)
          *(float4*)(xo + n0 + wn * 64 + nt * 32 + q4 * 8 + hh * 4) = make_float4(acc[nt][mt][q4 * 4 + 0], acc[nt][mt][q4 * 4 + 1], acc[nt][mt][q4 * 4 + 2], acc[nt][mt][q4 * 4 + 3]);
    }
    if (tid == 0) {
      int spins = 0;
      while (__hip_atomic_load(cnt, __ATOMIC_RELAXED, __HIP_MEMORY_SCOPE_AGENT) < 4u && ++spins < (1 << 22)) __builtin_amdgcn_s_sleep(1);
    }
    __syncthreads();
    const float* ng = P.in[ngi] + nlayer * 1024;
    const float* md = c.mod() + (size_t)(nlayer * 9 + b) * 6144 + moff;
#pragma unroll
    for (int mt = 0; mt < 4; ++mt) {
      const int tok = mb + mt * 32 + r32;
      const float* pp = part + (size_t)tok * 4;
      const float tot = __hip_atomic_load(pp, __ATOMIC_RELAXED, __HIP_MEMORY_SCOPE_AGENT) + __hip_atomic_load(pp + 1, __ATOMIC_RELAXED, __HIP_MEMORY_SCOPE_AGENT) +
                        __hip_atomic_load(pp + 2, __ATOMIC_RELAXED, __HIP_MEMORY_SCOPE_AGENT) + __hip_atomic_load(pp + 3, __ATOMIC_RELAXED, __HIP_MEMORY_SCOPE_AGENT);
      const float rstd = rsqrtf(tot * (1.f / 1024.f) + RMS_EPS);
#pragma unroll
      for (int nt = 0; nt < 2; ++nt) {
        uint2 pk[4];
#pragma unroll
        for (int q4 = 0; q4 < 4; ++q4) {
          const int n = n0 + wn * 64 + nt * 32 + q4 * 8 + hh * 4;
          const float4 gg = *(const float4*)(ng + n), sh = *(const float4*)(md + n), scl = *(const float4*)(md + 1024 + n);
          pk[q4] = pk4(acc[nt][mt][q4 * 4 + 0] * rstd * gg.x * (1.f + scl.x) + sh.x, acc[nt][mt][q4 * 4 + 1] * rstd * gg.y * (1.f + scl.y) + sh.y,
                       acc[nt][mt][q4 * 4 + 2] * rstd * gg.z * (1.f + scl.z) + sh.z, acc[nt][mt][q4 * 4 + 3] * rstd * gg.w * (1.f + scl.w) + sh.w);
        }
        u16* d = c.r1() + (size_t)tok * 1024 + n0 + wn * 64 + nt * 32 + hh * 16;
        *(uint4*)d = make_uint4(pk[0].x, pk[0].y, pk[1].x, pk[1].y);
        *(uint4*)(d + 8) = make_uint4(pk[2].x, pk[2].y, pk[3].x, pk[3].y);
      }
    }
  }
};

struct EpiSwiglu {
  const Ctx& c; int m0, n0;
  DI void operator()(f32x16 (&acc)[2][4], int wm, int wn, int lane) const {
    const int r32 = lane & 31, hh = lane >> 5;
    const int grp = (n0 + wn * 64) >> 6;
#pragma unroll
    for (int mt = 0; mt < 4; ++mt) {
      const int tok = m0 + wm * 128 + mt * 32 + r32;
      float o[16];
#pragma unroll
      for (int i = 0; i < 16; ++i) {
        const float gt = acc[0][mt][i], up = acc[1][mt][i];
        o[i] = gt * sigmoidf_(gt) * up;
      }
      u16* d = c.hid() + (size_t)tok * FH + grp * 32 + hh * 16;
      *(uint4*)d = make_uint4(pk2(o[0], o[1]), pk2(o[2], o[3]), pk2(o[4], o[5]), pk2(o[6], o[7]));
      *(uint4*)(d + 8) = make_uint4(pk2(o[8], o[9]), pk2(o[10], o[11]), pk2(o[12], o[13]), pk2(o[14], o[15]));
    }
  }
};

DI bf16x8 pack8(const f32x16& p, int s2) {
  uint4 u;
  if (s2 == 0) { u.x = pk2(p[0], p[1]); u.y = pk2(p[2], p[3]); u.z = pk2(p[4], p[5]); u.w = pk2(p[6], p[7]); }
  else { u.x = pk2(p[8], p[9]); u.y = pk2(p[10], p[11]); u.z = pk2(p[12], p[13]); u.w = pk2(p[14], p[15]); }
  return __builtin_bit_cast(bf16x8, u);
}

constexpr int KP = 104;
constexpr int VP = 136;
DI void mla_item(const Ctx& c, int b, int head, int qblk) {
  const int tid = otid(c.wv), lane = tid & 63, wave = tid >> 6;
  const int r32 = lane & 31, hh = lane >> 5;
  const int Lb = seq_len(b), s0 = b * 4096;
  u16(*Ks)[128][KP] = (u16(*)[128][KP])c.smem;
  u16(*Vs)[64][VP] = (u16(*)[64][VP])(c.smem + 2 * 128 * KP * 2);
  const u16* Q = c.qb() + (size_t)s0 * 768 + (size_t)head * Lb * 96;
  const u16* KN = c.kn() + (size_t)s0 * 512 + (size_t)head * Lb * 64;
  const u16* KR = c.kr() + (size_t)s0 * 32;
  const u16* VT = c.vt() + (size_t)s0 * 512 + (size_t)(head * 64) * Lb;
  const int q0 = qblk * 512 + wave * 64;
  bf16x8 qf[2][6];
#pragma unroll
  for (int qt = 0; qt < 2; ++qt)
#pragma unroll
    for (int ks = 0; ks < 6; ++ks) qf[qt][ks] = ldg8(Q + (size_t)(q0 + qt * 32 + r32) * 96 + ks * 16 + hh * 8);
  f32x16 o[2][2];
#pragma unroll
  for (int a = 0; a < 2; ++a)
#pragma unroll
    for (int bq = 0; bq < 2; ++bq) zero_acc(o[a][bq]);
  float lsum[2] = {0.f, 0.f};
  uint4 rk0, rk1, rk2, rv0, rv1;
  const int kkey0 = tid >> 3, kpart0 = tid & 7;
  const int kkey2 = tid >> 2, kpart2 = 8 + (tid & 3);
  const int vd0 = tid >> 4, vkc = tid & 15;
  const unsigned ko0 = kkey0 * 64 + kpart0 * 8, ko1 = ko0 + 64 * 64, ko2 = kkey2 * 32 + (tid & 3) * 8;
  const unsigned vo0 = (unsigned)vd0 * Lb + vkc * 8, vo1 = (unsigned)(vd0 + 32) * Lb + vkc * 8;
#define MGLOADK(k0_)                                       \
  {                                                        \
    const int k0__ = (k0_);                                \
    const u16* knb__ = KN + (size_t)k0__ * 64;             \
    const u16* krb__ = KR + (size_t)k0__ * 32;             \
    rk0 = *(const uint4*)(knb__ + ko0);                    \
    rk1 = *(const uint4*)(knb__ + ko1);                    \
    rk2 = *(const uint4*)(krb__ + ko2);                    \
  }
#define MGLOADV(k0_)                                       \
  {                                                        \
    const u16* vtb__ = VT + (k0_);                         \
    rv0 = *(const uint4*)(vtb__ + vo0);                    \
    rv1 = *(const uint4*)(vtb__ + vo1);                    \
  }
#define MSTOREK(buf_)                                  \
  {                                                    \
    const int b__ = (buf_);                            \
    *(uint4*)&Ks[b__][kkey0][kpart0 * 8] = rk0;        \
    *(uint4*)&Ks[b__][kkey0 + 64][kpart0 * 8] = rk1;   \
    *(uint4*)&Ks[b__][kkey2][kpart2 * 8] = rk2;        \
  }
#define MSTOREV(buf_)                                  \
  {                                                    \
    const int b__ = (buf_);                            \
    *(uint4*)&Vs[b__][vd0][vkc * 8] = rv0;             \
    *(uint4*)&Vs[b__][vd0 + 32][vkc * 8] = rv1;        \
  }
  const int ntile = Lb >> 7;
  __syncthreads();
  MGLOADK(0);
  MGLOADV(0);
  MSTOREK(0);
  MSTOREV(0);
  __syncthreads();
  const int pr = pi32(r32);
#pragma unroll 1
  for (int kt = 0; kt < ntile; ++kt) {
    const int buf = kt & 1;
    if (kt + 1 < ntile) MGLOADK((kt + 1) * 128);
#pragma unroll 2
    for (int kk = 0; kk < 4; ++kk) {
      f32x16 s[2];
      zero_acc(s[0]); zero_acc(s[1]);
#pragma unroll
      for (int ks = 0; ks < 6; ++ks) {
        const bf16x8 kf = *(const bf16x8*)&Ks[buf][kk * 32 + pr][ks * 16 + hh * 8];
        s[0] = MFMA(kf, qf[0][ks], s[0]);
        s[1] = MFMA(kf, qf[1][ks], s[1]);
      }
      bf16x8 pf[2][2];
#pragma unroll
      for (int qt = 0; qt < 2; ++qt) {
        float ls = 0.f;
#pragma unroll
        for (int i = 0; i < 16; ++i) { s[qt][i] = __builtin_amdgcn_exp2f(s[qt][i]); ls += s[qt][i]; }
        lsum[qt] += ls;
        pf[qt][0] = pack8(s[qt], 0);
        pf[qt][1] = pack8(s[qt], 1);
      }
#pragma unroll
      for (int dt = 0; dt < 2; ++dt)
#pragma unroll
        for (int s2 = 0; s2 < 2; ++s2) {
          const bf16x8 vf = *(const bf16x8*)&Vs[buf][dt * 32 + r32][kk * 32 + s2 * 16 + hh * 8];
          o[dt][0] = MFMA(vf, pf[0][s2], o[dt][0]);
          o[dt][1] = MFMA(vf, pf[1][s2], o[dt][1]);
        }
      if (kk == 1 && kt + 1 < ntile) {
        MSTOREK(buf ^ 1);
        MGLOADV((kt + 1) * 128);
      }
    }
    if (kt + 1 < ntile) MSTOREV(buf ^ 1);
    __syncthreads();
  }
#undef MGLOADK
#undef MGLOADV
#undef MSTOREK
#undef MSTOREV
  const int lane2 = otid(c.wv) & 63, r32b = lane2 & 31, hhb = lane2 >> 5;
#pragma unroll
  for (int qt = 0; qt < 2; ++qt) {
    float l = lsum[qt];
    l += lane_xor(l, lane2, 32);
    const float inv = 1.f / l;
    const int tok = b * 4096 + qblk * 512 + c.wv * 64 + qt * 32 + r32b;
    u16* dst = c.r1() + (size_t)tok * 1024 + 256 + head * 64;
#pragma unroll
    for (int dt = 0; dt < 2; ++dt)
#pragma unroll
      for (int q4 = 0; q4 < 4; ++q4)
        *(uint2*)(dst + dt * 32 + q4 * 8 + hhb * 4) = pk4(o[dt][qt][q4 * 4 + 0] * inv, o[dt][qt][q4 * 4 + 1] * inv, o[dt][qt][q4 * 4 + 2] * inv, o[dt][qt][q4 * 4 + 3] * inv);
  }
}

DI void na_item(const Ctx& c, const float* __restrict__ bias, int b, int row, int head, int qt) {
  const int lane = otid(c.wv) & 63;
  const int r32 = lane & 31, hh = lane >> 5;
  const int Lb = seq_len(b), s0 = b * 4096, rows = Lb >> 6;
  const int rstart = min(max(row - 4, 0), rows - 8);
  const int tok0 = s0 + row * 64 + qt * 32;
  bf16x8 qf[4];
#pragma unroll
  for (int ks = 0; ks < 4; ++ks) qf[ks] = ldg8(c.naq() + (size_t)(tok0 + r32) * 256 + head * 64 + ks * 16 + hh * 8);
  f32x16 o[2];
  zero_acc(o[0]); zero_acc(o[1]);
  float lsum = 0.f;
  const int pr = pi32(r32);
  const int qc = qt * 32 + r32;
  const int cs = min(max(qc - 8, 0), 48);
  const u16* VT = c.navt() + (size_t)s0 * 256 + (size_t)(head * 64) * Lb;
#pragma unroll 1
  for (int kri = 0; kri < 8; ++kri) {
    const int krow = rstart + kri;
    const float* bl = bias + (head * 15 + (krow - row + 7)) * 31;
#pragma unroll
    for (int kk = 0; kk < 2; ++kk) {
      const u16* kp = c.nak() + (size_t)(s0 + krow * 64 + kk * 32 + pr) * 256 + head * 64 + hh * 8;
      bf16x8 kf[4];
#pragma unroll
      for (int ks = 0; ks < 4; ++ks) kf[ks] = ldg8(kp + ks * 16);
      bf16x8 vf[2][2];
#pragma unroll
      for (int dt = 0; dt < 2; ++dt)
#pragma unroll
        for (int s2 = 0; s2 < 2; ++s2) vf[dt][s2] = ldg8(VT + (size_t)(dt * 32 + r32) * Lb + krow * 64 + kk * 32 + s2 * 16 + hh * 8);
      f32x16 s;
      zero_acc(s);
#pragma unroll
      for (int ks = 0; ks < 4; ++ks) s = MFMA(kf[ks], qf[ks], s);
      float ls = 0.f;
#pragma unroll
      for (int i = 0; i < 16; ++i) {
        const int kc = kk * 32 + 16 * ((i >> 3) & 1) + 8 * hh + 4 * ((i >> 2) & 1) + (i & 3);
        const bool valid = (kc >= cs) && (kc < cs + 16);
        const int bi = min(max(kc - qc + 15, 0), 30);
        const float p = valid ? __builtin_amdgcn_exp2f(s[i] + bl[bi]) : 0.f;
        s[i] = p; ls += p;
      }
      lsum += ls;
      const bf16x8 pf0 = pack8(s, 0), pf1 = pack8(s, 1);
#pragma unroll
      for (int dt = 0; dt < 2; ++dt) {
        o[dt] = MFMA(vf[dt][0], pf0, o[dt]);
        o[dt] = MFMA(vf[dt][1], pf1, o[dt]);
      }
    }
  }
  float l = lsum;
  l += lane_xor(l, lane, 32);
  const float inv = 1.f / l;
  u16* dst = c.r1() + (size_t)(tok0 + r32) * 1024 + head * 64;
#pragma unroll
  for (int dt = 0; dt < 2; ++dt)
#pragma unroll
    for (int q4 = 0; q4 < 4; ++q4)
      *(uint2*)(dst + dt * 32 + q4 * 8 + hh * 4) = pk4(o[dt][q4 * 4 + 0] * inv, o[dt][q4 * 4 + 1] * inv, o[dt][q4 * 4 + 2] * inv, o[dt][q4 * 4 + 3] * inv);
}

DI void carry_item(const Ctx& c, int layer, int it4) {
  const int tid = otid(c.wv);
  const int item = it4 * 4 + (tid >> 7);
  const int b = item >> 4, g = item & 15;
  const int dir = (tid >> 6) & 1, p = tid & 63;
  const int nch = seq_len(b) >> 5, gc0 = b * 128;
  const float2 lt = c.etab()[((size_t)((layer * 16 + g) * 2 + dir) * 64 + p) * 33 + 32];
  const float* __restrict__ sl_base = c.sloc() + (size_t)g * 256 + dir * 128 + p * 2;
  u16* __restrict__ ca_base = c.carry() + (size_t)g * 256 + dir * 128 + p * 2;
  float cr = 0.f, ci = 0.f;
  for (int k0 = 0; k0 < nch; k0 += 16) {
    float2 sl[16];
#pragma unroll
    for (int u = 0; u < 16; ++u) {
      const int ch = gc0 + (dir == 0 ? k0 + u : nch - 1 - (k0 + u));
      sl[u] = *(const float2*)(sl_base + (size_t)ch * 4096);
    }
#pragma unroll
    for (int u = 0; u < 16; ++u) {
      const int ch = gc0 + (dir == 0 ? k0 + u : nch - 1 - (k0 + u));
      *(unsigned*)(ca_base + (size_t)ch * 4096) = pk2(cr, ci);
      const float nr = lt.x * cr - lt.y * ci + sl[u].x;
      const float ni = lt.x * ci + lt.y * cr + sl[u].y;
      cr = nr; ci = ni;
    }
  }
}

template <bool COOP>
__global__ void __launch_bounds__(512, 2) mega(Params P, int ph_lo, int ph_hi, int dupmask) {
  __shared__ __attribute__((aligned(16))) unsigned char smem[2 * 2 * 256 * LP * 2];
  unsigned char* ws = P.ws;
  Ctx c{P, smem, ws, __builtin_amdgcn_readfirstlane((int)(threadIdx.x >> 6))};
  constexpr bool fuse = true;
#pragma unroll 1
  for (int ph2 = ph_lo * 2; ph2 < ph_hi * 2; ++ph2) {
    const int ph = ph2 >> 1;
    if ((ph2 & 1) && !(ph > 0 && ((dupmask >> ((ph - 1) % 10)) & 1))) continue;
    if (ph == 0) {
      phase_init(c);
    } else {
      const int l = (ph - 1) / 10, sub = (ph - 1) % 10;
      if (fuse && (sub == 7 || (sub == 0 && l > 0))) continue;
      int pg = -1, pl = 0, pstart = 0, pstride = 1;
      switch (sub) {
#if !defined(ONLY_SUB) || ONLY_SUB == 0
        case 0:
          if (l == 0) { pg = 0; pl = 0; pstart = (int)blockIdx.x; pstride = (int)gridDim.x; }
          break;
#endif
#if !defined(ONLY_SUB) || ONLY_SUB == 1
        case 1: {
          const XcdOrder xo(192, 7, 7);
          gemm_stream(smem, c.wv, xo.lb, xo.nlb, xo.total, 1024, 16,
            [&](int s) { int m, n; xo.decode(s, m, n); return TileDesc{ADesc{c.r1() + (size_t)m * 256 * 1024, 1024, nullptr, 0, 1 << 30}, c.win() + (size_t)n * 256 * 1024}; },
            [&](int s) { int m, n; xo.decode(s, m, n); return EpiG1{c, l, m * 256, n * 256}; });
          pg = 1; pl = l; pstart = tail_slot(xo.total, pstride);
        } break;
#endif
#if !defined(ONLY_SUB) || ONLY_SUB == 2
        case 2: {
          {
            const XcdOrder xo(192, 3, 3);
            gemm_stream(smem, c.wv, xo.lb, xo.nlb, xo.total, 384, 6,
              [&](int s) { int m, n; xo.decode(s, m, n); return TileDesc{ADesc{c.cq() + (size_t)m * 256 * 384, 384, nullptr, 0, 1 << 30}, c.wuq() + (size_t)n * 256 * 384}; },
              [&](int s) { int m, n; xo.decode(s, m, n); return EpiQ{c, l, m * 256, n * 256}; });
          }
          {
            const XcdOrder xo(192, 4, 4);
            gemm_stream(smem, c.wv, xo.lb, xo.nlb, xo.total, 256, 4,
              [&](int s) { int m, n; xo.decode(s, m, n); return TileDesc{ADesc{c.ckv() + (size_t)m * 256 * 256, 256, nullptr, 0, 1 << 30}, c.wukv() + (size_t)n * 256 * 256}; },
              [&](int s) { int m, n; xo.decode(s, m, n); return EpiKV{c, l, m * 256, n * 256}; });
          }
          gemm_stream(smem, c.wv, (int)blockIdx.x, (int)gridDim.x, 96, 512, 8,
            [&](int it) { const int g = it / 6, mt = it % 6; return TileDesc{ADesc{c.ub() + ((size_t)g * 1536 + mt * 256) * 512, 512, nullptr, 0, 1 << 30}, c.mint() + (size_t)g * 256 * 512}; },
            [&](int it) { const int g = it / 6, mt = it % 6; return EpiSloc{c, mt * 256, g, 0}; });
          const int tid = otid(c.wv);
          __syncthreads();
          float* bias = (float*)smem;
          for (int i = tid; i < 4 * 15 * 31; i += NTH) bias[i] = P.in[10][(size_t)l * 4 * 15 * 31 + i] * LOG2E;
          __syncthreads();
          for (int it = blockIdx.x; it < 768; it += gridDim.x) {
            int b, row;
            if (it < 512) { b = it >> 6; row = it & 63; } else { b = 8; row = it - 512; }
            na_item(c, bias, b, row, tid >> 7, (tid >> 6) & 1);
          }
          {
            const int lb = blockIdx.x >> 3, nlb = gridDim.x >> 3, xcd = blockIdx.x & 7;
            pg = 2; pl = l;
            if (nlb > 12) { pstride = 8 * (nlb - 12); pstart = lb < 12 ? (1 << 30) : xcd * (nlb - 12) + (lb - 12); }
            else { pstride = (int)gridDim.x; pstart = (int)blockIdx.x; }
          }
        } break;
#endif
#if !defined(ONLY_SUB) || ONLY_SUB == 3
        case 3: {
          for (int it = blockIdx.x; it < 36; it += gridDim.x) carry_item(c, l, it);
          for (int it = blockIdx.x; it < 768; it += gridDim.x) {
            int b, head, qblk;
            if (it < 256) { b = 8; head = it & 7; qblk = it >> 3; }
            else { const int j = it - 256; head = j & 7; b = (j >> 3) >> 3; qblk = (j >> 3) & 7; }
            mla_item(c, b, head, qblk);
          }
        } break;
#endif
#if !defined(ONLY_SUB) || ONLY_SUB == 4
        case 4:
          gemm_stream(smem, c.wv, (int)blockIdx.x, (int)gridDim.x, 192, 768, 12,
            [&](int it) { const int n = it & 1, u = it >> 1, g = u / 6, gc0 = (u % 6) * 256;
                          return TileDesc{ADesc{c.ub() + ((size_t)g * 1536 + gc0) * 512, 512, c.carry() + ((size_t)gc0 * 16 + g) * 256, 4096, 8}, c.kt() + ((size_t)g * 512 + n * 256) * 768}; },
            [&](int it) { const int n = it & 1, u = it >> 1, g = u / 6, gc0 = (u % 6) * 256; return EpiYs{c, gc0, g, n * 256}; });
          break;
#endif
#if !defined(ONLY_SUB) || ONLY_SUB == 5
        case 5: {
          const XcdOrder xo(192, 1, 1);
          gemm_stream(smem, c.wv, xo.lb, xo.nlb, xo.total, 256, 4,
            [&](int s) { int m, n; xo.decode(s, m, n); return TileDesc{ADesc{c.ysact() + (size_t)m * 256 * 256, 256, nullptr, 0, 1 << 30}, c.wglu()}; },
            [&](int s) { int m, n; xo.decode(s, m, n); return EpiGlu{c, l, m * 256, 0}; });
        } break;
#endif
#if !defined(ONLY_SUB) || ONLY_SUB == 6
        case 6: {
          const XcdOrder xo(192, 4, 4);
          gemm_stream(smem, c.wv, xo.lb, xo.nlb, xo.total, 1024, 16,
            [&](int s) { int m, n; xo.decode(s, m, n); return TileDesc{ADesc{c.r1() + (size_t)m * 256 * 1024, 1024, nullptr, 0, 1 << 30}, c.wout() + (size_t)n * 256 * 1024}; },
            [&](int s) { int m, n; xo.decode(s, m, n); return EpiRes{c, l, m * 256, n * 256, 2, l == 0, fuse ? l * 2 : -1, 30, l, 3072}; });
        } break;
#endif
#if !defined(ONLY_SUB) || ONLY_SUB == 7
        case 7: break;
#endif
#if !defined(ONLY_SUB) || ONLY_SUB == 8
        case 8: {
          const XcdOrder xo(192, 22, 11);
          gemm_stream(smem, c.wv, xo.lb, xo.nlb, xo.total, 1024, 16,
            [&](int s) { int m, n; xo.decode(s, m, n); return TileDesc{ADesc{c.r1() + (size_t)m * 256 * 1024, 1024, nullptr, 0, 1 << 30}, c.wgu() + (size_t)n * 256 * 1024}; },
            [&](int s) { int m, n; xo.decode(s, m, n); return EpiSwiglu{c, m * 256, n * 256}; });
          if (l + 1 < DEPTH) { pg = 0; pl = l + 1; pstart = tail_slot(xo.total, pstride); }
        } break;
#endif
#if !defined(ONLY_SUB) || ONLY_SUB == 9
        case 9: {
          const XcdOrder xo(192, 4, 4);
          gemm_stream(smem, c.wv, xo.lb, xo.nlb, xo.total, FH, 44,
            [&](int s) { int m, n; xo.decode(s, m, n); return TileDesc{ADesc{c.hid() + (size_t)m * 256 * FH, FH, nullptr, 0, 1 << 30}, c.wdn() + (size_t)n * 256 * FH}; },
            [&](int s) { int m, n; xo.decode(s, m, n); return EpiRes{c, l, m * 256, n * 256, 5, false, (fuse && l + 1 < DEPTH) ? l * 2 + 1 : -1, 6, l + 1, 0}; });
        } break;
#endif
      }
      if (pg >= 0) prep_items(c, pl, pg, pstart, pstride);
      if (sub == 0) norm_rows(c, 0, 0);
    }
    if (COOP) {
      if (ph2 + 1 < ph_hi * 2) cg::this_grid().sync();
    }
  }
}

extern "C" void kernel_launch(void* const* d_in, const int* in_sizes, int n_in, void* d_out, int out_size, void* d_ws, size_t ws_size, hipStream_t stream) {
  if (ws_size < O_END) { fprintf(stderr, "workspace too small: %zu < %zu\n", ws_size, (size_t)O_END); return; }
  Params p{};
  for (int i = 0; i < 34; ++i) p.in[i] = (const float*)d_in[i];
  p.out = (float*)d_out;
  p.ws = (unsigned char*)d_ws;
  static int grid_blocks = 0;
  if (!grid_blocks) {
    int dev = 0, cus = 0, per_cu = 0;
    (void)hipGetDevice(&dev);
    (void)hipDeviceGetAttribute(&cus, hipDeviceAttributeMultiprocessorCount, dev);
    (void)hipOccupancyMaxActiveBlocksPerMultiprocessor(&per_cu, mega<true>, NTH, 0);
    if (per_cu > 1) per_cu = 1;
    grid_blocks = (cus * per_cu) & ~31;
  }
  int lo = 0, hi = 41, dup = DUPMASK;
  void* args[] = {&p, &lo, &hi, &dup};
  hipError_t e = hipLaunchCooperativeKernel((void*)mega<true>, dim3(grid_blocks), dim3(NTH), args, 0, stream);
  if (e != hipSuccess) fprintf(stderr, "cooperative launch failed: %s (grid %d)\n", hipGetErrorString(e), grid_blocks);
}
```

```cpp
#include <hip/hip_runtime.h>
#include <hip/hip_cooperative_groups.h>
#include <cstdio>
#include <cstdint>
namespace cg = cooperative_groups;

typedef unsigned short u16;
typedef __attribute__((ext_vector_type(8))) short bf16x8;
typedef __attribute__((ext_vector_type(16))) float f32x16;
typedef __attribute__((ext_vector_type(2))) __bf16 bf2_t;
typedef __attribute__((ext_vector_type(2))) float f2_t;
#define DI __device__ __forceinline__
#define MFMA(a, b, c) __builtin_amdgcn_mfma_f32_32x32x16_bf16((a), (b), (c), 0, 0, 0)

#ifndef DUPMASK
#define DUPMASK 0
#endif
constexpr int NTH = 512;
constexpr int TT = 49152, TP = 32768, NSEQ = 9, DEPTH = 4, FH = 2816;
constexpr float RMS_EPS = 1e-6f;
constexpr float LOG2E = 1.4426950408889634f;
constexpr float QS_NA = 0.125f * LOG2E;
constexpr float QS_MLA = 0.10206207261596575f * LOG2E;

constexpr size_t AL(size_t x) { return (x + 255) & ~(size_t)255; }
constexpr size_t O_MOD = 0;
constexpr size_t O_ROPE = O_MOD + AL((size_t)DEPTH * NSEQ * 6144 * 4);
constexpr size_t O_ETAB = O_ROPE + AL((size_t)16384 * 32 * 4);
constexpr size_t O_BBAR = O_ETAB + AL((size_t)DEPTH * 16 * 2 * 64 * 33 * 8);
constexpr size_t O_KTAB = O_BBAR + AL((size_t)DEPTH * 16 * 2 * 64 * 16 * 8);
constexpr size_t O_SSQ = O_KTAB + AL((size_t)DEPTH * 16 * 2 * 32 * 256 * 4);
constexpr size_t O_WIN = O_SSQ + AL((size_t)TT * 16 * 4);
constexpr size_t O_WUQ = O_WIN + AL((size_t)1792 * 1024 * 2);
constexpr size_t O_WUKV = O_WUQ + AL((size_t)768 * 384 * 2);
constexpr size_t O_WGLU = O_WUKV + AL((size_t)1024 * 256 * 2);
constexpr size_t O_WOUT = O_WGLU + AL((size_t)256 * 256 * 2);
constexpr size_t O_WGU = O_WOUT + AL((size_t)1024 * 1024 * 2);
constexpr size_t O_WDN = O_WGU + AL((size_t)5632 * 1024 * 2);
constexpr size_t O_KT = O_WDN + AL((size_t)1024 * 2816 * 2);
constexpr size_t O_MINT = O_KT + AL((size_t)16 * 512 * 768 * 2);
constexpr size_t O_R1 = O_MINT + AL((size_t)16 * 256 * 512 * 2);
constexpr size_t O_SLOC = O_R1 + AL((size_t)TT * 1024 * 2);
constexpr size_t O_X = O_SLOC + AL((size_t)1536 * 16 * 256 * 4);
constexpr size_t O_NAQ = O_X;
constexpr size_t O_NAK = O_NAQ + AL((size_t)TT * 256 * 2);
constexpr size_t O_NAVT = O_NAK + AL((size_t)TT * 256 * 2);
constexpr size_t O_CQ = O_NAVT + AL((size_t)TT * 256 * 2);
constexpr size_t O_CKV = O_CQ + AL((size_t)TT * 384 * 2);
constexpr size_t O_UB = O_CKV + AL((size_t)TT * 256 * 2);
constexpr size_t O_QB = O_UB + AL((size_t)TT * 256 * 2);
constexpr size_t O_KN = O_QB + AL((size_t)TT * 768 * 2);
constexpr size_t O_KR = O_KN + AL((size_t)TT * 512 * 2);
constexpr size_t O_VT = O_KR + AL((size_t)TT * 32 * 2);
constexpr size_t O_PART = O_VT + AL((size_t)TT * 512 * 2);
constexpr size_t O_CNT = O_PART + AL((size_t)8 * TT * 4 * 4);
constexpr size_t O_END = O_CNT + AL((size_t)8 * 192 * 4);
constexpr size_t O_HID = O_X;
constexpr size_t O_CARRY = O_NAK;
constexpr size_t O_YSACT = O_NAVT;
static_assert(O_END <= (size_t)536870912, "workspace too large");
static_assert(O_HID + (size_t)TT * FH * 2 <= O_END, "hid does not fit");

struct Params { const float* in[34]; float* out; unsigned char* ws; };

DI unsigned pk2(float x, float y) { f2_t v = {x, y}; bf2_t b = __builtin_convertvector(v, bf2_t); return __builtin_bit_cast(unsigned, b); }
DI uint2 pk4(float a, float b, float c, float d) { uint2 r; r.x = pk2(a, b); r.y = pk2(c, d); return r; }
DI u16 bf1(float x) { return (u16)(pk2(x, 0.f) & 0xffffu); }
DI float bflo(unsigned v) { return __uint_as_float(v << 16); }
DI float bfhi(unsigned v) { return __uint_as_float(v & 0xffff0000u); }
DI int seq_of(int t) { return t < TP ? (t >> 12) : 8; }
DI int seq_len(int b) { return b < 8 ? 4096 : 16384; }
DI int pi32(int r) { return (r & 0x13) | ((r & 4) << 1) | ((r & 8) >> 1); }
DI float sigmoidf_(float x) { return __builtin_amdgcn_rcpf(1.f + __builtin_amdgcn_exp2f(-LOG2E * x)); }
DI float lane_xor(float v, int lane, int o) { return __int_as_float(__builtin_amdgcn_ds_bpermute((lane ^ o) << 2, __float_as_int(v))); }
DI float wave_sum(float v, int lane) {
#pragma unroll
  for (int o = 32; o >= 1; o >>= 1) v += lane_xor(v, lane, o);
  return v;
}
DI void zero_acc(f32x16& a) {
#pragma unroll
  for (int i = 0; i < 16; ++i) a[i] = 0.f;
}
DI bf16x8 ldg8(const u16* p) { return *(const bf16x8*)p; }
DI int otid(int wv) { int lane; asm volatile("v_mbcnt_lo_u32_b32 %0, -1, 0\n\tv_mbcnt_hi_u32_b32 %0, -1, %0" : "=v"(lane)); return wv * 64 + lane; }

struct ADesc { const u16* p0; long pitch0; const u16* p1; long pitch1; int ksplit; };
constexpr int LP = 72;

#define RAW_BARRIER() do { asm volatile("s_waitcnt lgkmcnt(0)" ::: "memory"); __builtin_amdgcn_s_barrier(); } while (0)
struct TileDesc { ADesc ad; const u16* bt; };

template <class DescFn, class EpiFn>
DI void gemm_stream(unsigned char* smem, const int wv, const int start, const int stride, const int end, const int ldb, const int nk, DescFn&& desc, EpiFn&& mkepi) {
  if (start >= end) return;
  const int tid = otid(wv), lane = tid & 63, wave = wv;
  const int wm = wave & 1, wn = wave >> 1;
  const int r32 = lane & 31, hh = lane >> 5;
  const bool isA = wave < 4;
  const int w3 = wave & 3;
  const int c0 = ((lane & 7) ^ (lane >> 4)) * 8, c1 = ((lane & 7) ^ (4 + (lane >> 4))) * 8;
  const int lrow = w3 * 64 + (lane >> 3);
  unsigned char* const ldst = smem + (isA ? 0 : 32768) + w3 * 8192;
#define DMA(td_, kt_, stage_)                                                                                    \
  {                                                                                                              \
    const int kt__ = (kt_);                                                                                      \
    const u16* src__; long pitch__;                                                                              \
    if (isA) {                                                                                                   \
      const bool first__ = kt__ < (td_).ad.ksplit;                                                               \
      src__ = (first__ ? (td_).ad.p0 : (td_).ad.p1) + (first__ ? kt__ : kt__ - (td_).ad.ksplit) * 64;            \
      pitch__ = first__ ? (td_).ad.pitch0 : (td_).ad.pitch1;                                                     \
    } else { src__ = (td_).bt + kt__ * 64; pitch__ = ldb; }                                                      \
    src__ += (long)lrow * pitch__;                                                                               \
    unsigned char* d__ = ldst + (stage_) * 65536;                                                                \
    _Pragma("unroll") for (int i = 0; i < 8; ++i)                                                                \
      __builtin_amdgcn_global_load_lds((const unsigned*)(src__ + (long)(i * 8) * pitch__ + ((i & 1) ? c1 : c0)), \
                                       (unsigned*)(d__ + i * 1024), 16, 0, 0);                                   \
  }
  const int sw = (r32 >> 1) & 7;
  const unsigned aoff = (unsigned)(wm * 128 + r32) * 128, boff = 32768u + (unsigned)(wn * 64 + r32) * 128;
#define LOADF(ks, S)                                                                                \
  {                                                                                                 \
    const unsigned co__ = (unsigned)((((ks) * 2 + hh) ^ sw) << 4);                                  \
    S##w0 = *(const bf16x8*)(sbase + boff + co__);                                                  \
    S##w1 = *(const bf16x8*)(sbase + boff + 32 * 128 + co__);                                       \
    S##t0 = *(const bf16x8*)(sbase + aoff + co__);                                                  \
    S##t1 = *(const bf16x8*)(sbase + aoff + 32 * 128 + co__);                                       \
    S##t2 = *(const bf16x8*)(sbase + aoff + 64 * 128 + co__);                                       \
    S##t3 = *(const bf16x8*)(sbase + aoff + 96 * 128 + co__);                                       \
  }
#define MMA(S)                                                                                      \
  {                                                                                                 \
    acc[0][0] = MFMA(S##w0, S##t0, acc[0][0]);                                                      \
    acc[1][0] = MFMA(S##w1, S##t0, acc[1][0]);                                                      \
    acc[0][1] = MFMA(S##w0, S##t1, acc[0][1]);                                                      \
    acc[1][1] = MFMA(S##w1, S##t1, acc[1][1]);                                                      \
    acc[0][2] = MFMA(S##w0, S##t2, acc[0][2]);                                                      \
    acc[1][2] = MFMA(S##w1, S##t2, acc[1][2]);                                                      \
    acc[0][3] = MFMA(S##w0, S##t3, acc[0][3]);                                                      \
    acc[1][3] = MFMA(S##w1, S##t3, acc[1][3]);                                                      \
  }
  int cur_i = start;
  TileDesc cur = desc(cur_i);
  DMA(cur, 0, 0);
#pragma unroll 1
  while (true) {
    const int nxt_i = cur_i + stride;
    const bool has_next = nxt_i < end;
    TileDesc nxt = cur;
    if (has_next) nxt = desc(nxt_i);
    f32x16 acc[2][4];
#pragma unroll
    for (int a = 0; a < 2; ++a)
#pragma unroll
      for (int b = 0; b < 4; ++b) zero_acc(acc[a][b]);
    bf16x8 Fw0, Fw1, Ft0, Ft1, Ft2, Ft3, Gw0, Gw1, Gt0, Gt1, Gt2, Gt3;
#pragma unroll 1
    for (int kt = 0; kt < nk; ++kt) {
      const int buf = kt & 1;
      asm volatile("s_waitcnt vmcnt(0)" ::: "memory");
      RAW_BARRIER();
      if (wave < 4) {
        if (kt + 1 < nk) { DMA(cur, kt + 1, buf ^ 1); }
        else if (has_next) { DMA(nxt, 0, 0); }
      }
      const unsigned char* sbase = smem + buf * 65536;
      LOADF(0, F);
      LOADF(1, G);
      MMA(F);
      if (wave >= 4) {
        if (kt + 1 < nk) { DMA(cur, kt + 1, buf ^ 1); }
        else if (has_next) { DMA(nxt, 0, 0); }
      }
      MMA(G);
      LOADF(2, F);
      LOADF(3, G);
      MMA(F);
      MMA(G);
    }
    mkepi(cur_i)(acc, wm, wn, lane);
    if (!has_next) break;
    cur = nxt;
    cur_i = nxt_i;
  }
  asm volatile("s_waitcnt vmcnt(0)" ::: "memory");
  RAW_BARRIER();
#undef LOADF
#undef MMA
#undef DMA
}

struct XcdOrder {
  int xcd, lb, nlb, mper, NG, total;
  DI XcdOrder(int MT, int NT, int NG_) { xcd = blockIdx.x & 7; lb = blockIdx.x >> 3; nlb = gridDim.x >> 3; mper = MT >> 3; NG = NG_; total = mper * NT; }
  DI void decode(int s, int& m, int& n) const {
    const int grp = s / (mper * NG), rem = s - grp * (mper * NG);
    m = xcd * mper + rem / NG; n = grp * NG + rem % NG;
  }
};

DI void rope_store(const f32x16& a, float rstd, const float* __restrict__ g, const float* __restrict__ ropel, float sc, u16* dst, int hh) {
  uint2 pk[4];
#pragma unroll
  for (int q4 = 0; q4 < 2; ++q4) {
    const int j0 = 8 * q4 + 4 * hh;
    const float4 g1 = *(const float4*)(g + j0), g2 = *(const float4*)(g + 16 + j0);
    const float4 c = *(const float4*)(ropel + j0), s = *(const float4*)(ropel + 16 + j0);
    const float x1[4] = {a[q4 * 4 + 0] * rstd * g1.x, a[q4 * 4 + 1] * rstd * g1.y, a[q4 * 4 + 2] * rstd * g1.z, a[q4 * 4 + 3] * rstd * g1.w};
    const float x2[4] = {a[q4 * 4 + 8] * rstd * g2.x, a[q4 * 4 + 9] * rstd * g2.y, a[q4 * 4 + 10] * rstd * g2.z, a[q4 * 4 + 11] * rstd * g2.w};
    const float cc[4] = {c.x, c.y, c.z, c.w}, ss[4] = {s.x, s.y, s.z, s.w};
    float o1[4], o2[4];
#pragma unroll
    for (int j = 0; j < 4; ++j) { o1[j] = (x1[j] * cc[j] - x2[j] * ss[j]) * sc; o2[j] = (x1[j] * ss[j] + x2[j] * cc[j]) * sc; }
    pk[q4] = pk4(o1[0], o1[1], o1[2], o1[3]);
    pk[2 + q4] = pk4(o2[0], o2[1], o2[2], o2[3]);
  }
  *(uint4*)(dst + hh * 16) = make_uint4(pk[0].x, pk[0].y, pk[1].x, pk[1].y);
  *(uint4*)(dst + hh * 16 + 8) = make_uint4(pk[2].x, pk[2].y, pk[3].x, pk[3].y);
}

DI float tile_ssq(const f32x16& a) {
  float s = 0.f;
#pragma unroll
  for (int i = 0; i < 16; ++i) s += a[i] * a[i];
  return s;
}

struct Ctx {
  const Params& P;
  unsigned char* smem;
  unsigned char* ws;
  int wv;
  DI float* mod() const { return (float*)(ws + O_MOD); }
  DI float* rope() const { return (float*)(ws + O_ROPE); }
  DI float* ssq() const { return (float*)(ws + O_SSQ); }
  DI float* sloc() const { return (float*)(ws + O_SLOC); }
  DI float* ktab() const { return (float*)(ws + O_KTAB); }
  DI float* part() const { return (float*)(ws + O_PART); }
  DI unsigned* cnt() const { return (unsigned*)(ws + O_CNT); }
  DI float2* etab() const { return (float2*)(ws + O_ETAB); }
  DI float2* bbar() const { return (float2*)(ws + O_BBAR); }
  DI u16* win() const { return (u16*)(ws + O_WIN); }
  DI u16* wuq() const { return (u16*)(ws + O_WUQ); }
  DI u16* wukv() const { return (u16*)(ws + O_WUKV); }
  DI u16* wglu() const { return (u16*)(ws + O_WGLU); }
  DI u16* wout() const { return (u16*)(ws + O_WOUT); }
  DI u16* wgu() const { return (u16*)(ws + O_WGU); }
  DI u16* wdn() const { return (u16*)(ws + O_WDN); }
  DI u16* kt() const { return (u16*)(ws + O_KT); }
  DI u16* mint() const { return (u16*)(ws + O_MINT); }
  DI u16* r1() const { return (u16*)(ws + O_R1); }
  DI u16* naq() const { return (u16*)(ws + O_NAQ); }
  DI u16* nak() const { return (u16*)(ws + O_NAK); }
  DI u16* navt() const { return (u16*)(ws + O_NAVT); }
  DI u16* cq() const { return (u16*)(ws + O_CQ); }
  DI u16* ckv() const { return (u16*)(ws + O_CKV); }
  DI u16* ub() const { return (u16*)(ws + O_UB); }
  DI u16* qb() const { return (u16*)(ws + O_QB); }
  DI u16* kn() const { return (u16*)(ws + O_KN); }
  DI u16* kr() const { return (u16*)(ws + O_KR); }
  DI u16* vt() const { return (u16*)(ws + O_VT); }
  DI u16* hid() const { return (u16*)(ws + O_HID); }
  DI u16* carry() const { return (u16*)(ws + O_CARRY); }
  DI u16* ysact() const { return (u16*)(ws + O_YSACT); }
};

__device__ const double INV_FREQ_TURNS[16] = {1.59154943091895346e-01, 8.94994016088910133e-02, 5.03292121044870353e-02, 2.83021958306233987e-02,
                                              1.59154943091895339e-02, 8.94994016088910237e-03, 5.03292121044870370e-03, 2.83021958306233987e-03,
                                              1.59154943091895356e-03, 8.94994016088910237e-04, 5.03292121044870326e-04, 2.83021958306233954e-04,
                                              1.59154943091895351e-04, 8.94994016088910182e-05, 5.03292121044870354e-05, 2.83021958306233961e-05};

DI void phase_init(const Ctx& c) {
  const Params& P = c.P;
  const int tid = otid(c.wv);
  if (blockIdx.x == 0) for (int i = tid; i < 8 * 192; i += NTH) c.cnt()[i] = 0u;
  for (int it = blockIdx.x; it < 640; it += gridDim.x) {
    __syncthreads();
    if (it < 384) {
      const int l = it / 96, n0 = (it % 96) * 64;
      float* sc = (float*)c.smem;
      float* red = sc + 9 * 1024;
      for (int i = tid; i < 9 * 1024; i += NTH) {
        const int b = i >> 10, k = i & 1023;
        const float v = b < 8 ? P.in[2][b * 1024 + k] : P.in[3][k];
        sc[i] = v / (1.f + __expf(-v));
      }
      __syncthreads();
      const int col = tid & 63, kq = tid >> 6;
      float acc[9];
#pragma unroll
      for (int b = 0; b < 9; ++b) acc[b] = 0.f;
      const float* w = P.in[4] + (size_t)l * 1024 * 6144 + n0 + col;
      for (int k = kq * 128; k < kq * 128 + 128; ++k) {
        const float wv = w[(size_t)k * 6144];
#pragma unroll
        for (int b = 0; b < 9; ++b) acc[b] += sc[b * 1024 + k] * wv;
      }
#pragma unroll
      for (int b = 0; b < 9; ++b) red[(kq * 9 + b) * 64 + col] = acc[b];
      __syncthreads();
      for (int i = tid; i < 9 * 64; i += NTH) {
        const int b = i >> 6, cc = i & 63;
        float v = 0.f;
#pragma unroll
        for (int q = 0; q < 8; ++q) v += red[(q * 9 + b) * 64 + cc];
        c.mod()[(size_t)(l * 9 + b) * 6144 + n0 + cc] = v + P.in[5][l * 6144 + n0 + cc];
      }
    } else if (it < 512) {
      const int base = (it - 384) * 2048;
      for (int i = tid; i < 2048; i += NTH) {
        const int idx = base + i, pos = idx >> 4, j = idx & 15;
        double t = (double)pos * INV_FREQ_TURNS[j];
        t -= __builtin_rint(t);
        const float tf = (float)t;
        c.rope()[pos * 32 + j] = __builtin_amdgcn_cosf(tf);
        c.rope()[pos * 32 + 16 + j] = __builtin_amdgcn_sinf(tf);
      }
    } else {
      const int id = it - 512, l = id >> 5, g = (id >> 1) & 15, dir = id & 1;
      float* Ere = (float*)c.smem;
      float* Eim = Ere + 64 * 33;
      float* Bre = Eim + 64 * 33;
      float* Bim = Bre + 64 * 16;
      const int ag = (l * 2 + dir) * 16 + g;
      const float dt = __expf(P.in[25][ag]);
      for (int i = tid; i < 64 * 33; i += NTH) {
        const int p = i / 33, d = i - p * 33;
        const float are = P.in[19][ag * 64 + p], aim = P.in[20][ag * 64 + p];
        const float mag = __expf(are * dt * (float)d);
        double t = (double)aim * (double)dt * (double)d * 0.15915494309189535;
        t -= __builtin_rint(t);
        const float tf = (float)t;
        const float er = mag * __builtin_amdgcn_cosf(tf), ei = mag * __builtin_amdgcn_sinf(tf);
        Ere[i] = er; Eim[i] = ei;
        c.etab()[(size_t)((l * 16 + g) * 2 + dir) * 64 * 33 + i] = make_float2(er, ei);
      }
      for (int i = tid; i < 64 * 16; i += NTH) {
        const int p = i >> 4, cc = i & 15;
        const float are = P.in[19][ag * 64 + p], aim = P.in[20][ag * 64 + p];
        const float xr = are * dt;
        double t = (double)aim * (double)dt * 0.15915494309189535;
        t -= __builtin_rint(t);
        const float tf = (float)t;
        const float cs = __builtin_amdgcn_cosf(tf), sn = __builtin_amdgcn_sinf(tf), sh = __builtin_amdgcn_sinf(0.5f * tf);
        const float em1 = expm1f(xr);
        const float nr = em1 * cs - 2.f * sh * sh, ni = (em1 + 1.f) * sn;
        const float den = 1.f / (are * are + aim * aim);
        const float qr = (nr * are + ni * aim) * den, qi = (ni * are - nr * aim) * den;
        const float br = P.in[21][(size_t)(ag * 64 + p) * 16 + cc], bi = P.in[22][(size_t)(ag * 64 + p) * 16 + cc];
        const float rr = qr * br - qi * bi, ri = qr * bi + qi * br;
        Bre[i] = rr; Bim[i] = ri;
        c.bbar()[(size_t)(((l * 16 + g) * 2 + dir) * 64) * 16 + i] = make_float2(rr, ri);
      }
      __syncthreads();
      {
        const int pr_ = tid & 255, dh = tid >> 8;
        const int co = pr_ >> 4, ci = pr_ & 15;
        float acc[16];
#pragma unroll
        for (int d = 0; d < 16; ++d) acc[d] = 0.f;
        const float* cre = P.in[23] + (size_t)(ag * 16 + co) * 64;
        const float* cim = P.in[24] + (size_t)(ag * 16 + co) * 64;
        for (int p = 0; p < 64; ++p) {
          const float cr = cre[p], cim_ = cim[p];
          const float br = Bre[p * 16 + ci], bi = Bim[p * 16 + ci];
          const float gr = cr * br - cim_ * bi, gi = cr * bi + cim_ * br;
#pragma unroll
          for (int d = 0; d < 16; ++d) acc[d] += gr * Ere[p * 33 + dh * 16 + d] - gi * Eim[p * 33 + dh * 16 + d];
        }
#pragma unroll
        for (int d = 0; d < 16; ++d) c.ktab()[((size_t)(((l * 16 + g) * 2 + dir) * 32 + dh * 16 + d)) * 256 + pr_] = acc[d];
      }
    }
  }
}

DI int perm_col(int kind, int n) {
  switch (kind) {
    case 0: return n < 1408 ? n : (n < 1440 ? n - 1408 + 1664 : n - 1440 + 1408);
    case 1: { const int h = n / 96, j = n - h * 96; return j < 64 ? h * 64 + j : 512 + h * 32 + (j - 64); }
    case 2: { const int h = n >> 7, j = n & 127; return j < 64 ? h * 64 + j : 512 + h * 64 + (j - 64); }
    case 5: return (n >> 5) * 64 + (n & 31);
    case 6: return (n >> 5) * 64 + 32 + (n & 31);
    default: return n;
  }
}

DI void conv_tile(unsigned char* smem, const int wv, const float* __restrict__ src, u16* __restrict__ dst, int K, int N, int kind, const float* __restrict__ gain, int ktile, int ntile, bool kperm = false) {
  u16(*T)[LP] = (u16(*)[LP])smem;
  const int tid = otid(wv);
  const int nl = tid & 63, kq = tid >> 6;
  const int n = ntile * 64 + nl, k0 = ktile * 64;
  __syncthreads();
#pragma unroll 4
  for (int i = 0; i < 8; ++i) {
    const int k = kq * 8 + i;
    float v = 0.f;
    if (n < N) { v = src[(size_t)(k0 + k) * N + n]; if (gain) v *= gain[k0 + k]; }
    T[nl][k] = bf1(v);
  }
  __syncthreads();
  const int row = tid >> 3, seg = tid & 7;
  const int nn = ntile * 64 + row;
  if (nn < N) {
    const int dr = perm_col(kind, nn);
    uint4 v0;
    if (kperm) {
      const int base = (seg >> 2) * 32 + (seg & 1) * 16 + ((seg >> 1) & 1) * 4;
      const uint2 lo = *(const uint2*)&T[row][base], hi = *(const uint2*)&T[row][base + 8];
      v0 = make_uint4(lo.x, lo.y, hi.x, hi.y);
    } else {
      v0 = *(const uint4*)&T[row][seg * 8];
    }
    *(uint4*)(dst + (size_t)dr * K + k0 + seg * 8) = v0;
  }
}

DI void norm_rows(const Ctx& c, int layer, int which) {
  const Params& P = c.P;
  const int tid_ = otid(c.wv);
  const int lane = tid_ & 63, wave = tid_ >> 6;
  const float* g = P.in[which ? 30 : 6] + layer * 1024;
  for (int tok0 = (blockIdx.x * 8 + wave) * 2; tok0 < TT; tok0 += gridDim.x * 16) {
    float4 v[2][4];
    float ss[2] = {0.f, 0.f};
#pragma unroll
    for (int t = 0; t < 2; ++t) {
      const int tok = tok0 + t;
      const float* x;
      if (layer == 0 && which == 0) x = tok < TP ? P.in[0] + (size_t)tok * 1024 : P.in[1] + (size_t)(tok - TP) * 1024;
      else x = P.out + (size_t)tok * 1024;
#pragma unroll
      for (int j = 0; j < 4; ++j) v[t][j] = *(const float4*)(x + j * 256 + lane * 4);
    }
#pragma unroll
    for (int t = 0; t < 2; ++t) {
#pragma unroll
      for (int j = 0; j < 4; ++j) ss[t] += v[t][j].x * v[t][j].x + v[t][j].y * v[t][j].y + v[t][j].z * v[t][j].z + v[t][j].w * v[t][j].w;
      ss[t] = wave_sum(ss[t], lane);
    }
    const int b = seq_of(tok0);
    const float* md = c.mod() + (size_t)(layer * 9 + b) * 6144 + (which ? 3072 : 0);
#pragma unroll
    for (int j = 0; j < 4; ++j) {
      const int idx = j * 256 + lane * 4;
      const float4 gg = *(const float4*)(g + idx), sh = *(const float4*)(md + idx), scl = *(const float4*)(md + 1024 + idx);
#pragma unroll
      for (int t = 0; t < 2; ++t) {
        const float rstd = rsqrtf(ss[t] * (1.f / 1024.f) + RMS_EPS);
        const float o0 = v[t][j].x * rstd * gg.x * (1.f + scl.x) + sh.x;
        const float o1 = v[t][j].y * rstd * gg.y * (1.f + scl.y) + sh.y;
        const float o2 = v[t][j].z * rstd * gg.z * (1.f + scl.z) + sh.z;
        const float o3 = v[t][j].w * rstd * gg.w * (1.f + scl.w) + sh.w;
        *(uint2*)(c.r1() + (size_t)(tok0 + t) * 1024 + ((idx & ~31) + ((idx >> 2) & 1) * 16 + ((idx >> 3) & 3) * 4)) = pk4(o0, o1, o2, o3);
      }
    }
  }
}

constexpr int PREP_NA = 825, PREP_NB = 784, PREP_NC = 2112;
DI void prep_items(const Ctx& c, int l, int group, int start, int stride) {
  const Params& P = c.P;
  const int tid = otid(c.wv);
  constexpr int C0 = 432, C1 = C0 + 72, C2 = C1 + 64, C3 = C2 + 16, C4 = C3 + 256, C5 = C4 + 704, C6 = C5 + 704, C7 = C6 + 704;
  constexpr int CZ = C7 + 1, CK = CZ + 512, CM = CK + 256;
  static_assert(C2 + 1 + (CM - CK) == PREP_NA && (C4 - C2) + (CK - CZ) == PREP_NB && (C7 - C4) == PREP_NC, "prep item counts");
  const int nitems = group == 0 ? PREP_NA : (group == 1 ? PREP_NB : PREP_NC);
  for (int gi = start; gi < nitems; gi += stride) {
    int it;
    if (group == 0) it = gi < C2 ? gi : (gi == C2 ? C7 : CK + (gi - C2 - 1));
    else if (group == 1) it = gi < (C4 - C2) ? C2 + gi : CZ + (gi - (C4 - C2));
    else it = C4 + gi;
    if (it < C0) conv_tile(c.smem, c.wv, P.in[7] + (size_t)l * 1024 * 1696, c.win(), 1024, 1696, 0, nullptr, it / 27, it % 27, true);
    else if (it < C1) { const int j = it - C0; conv_tile(c.smem, c.wv, P.in[13] + (size_t)l * 384 * 768, c.wuq(), 384, 768, 1, P.in[11] + l * 384, j / 12, j % 12, true); }
    else if (it < C2) { const int j = it - C1; conv_tile(c.smem, c.wv, P.in[14] + (size_t)l * 256 * 1024, c.wukv(), 256, 1024, 2, P.in[12] + l * 256, j / 16, j % 16, true); }
    else if (it < C3) { const int j = it - C2; conv_tile(c.smem, c.wv, P.in[27] + (size_t)l * 256 * 256, c.wglu(), 256, 256, 3, nullptr, j / 4, j % 4); }
    else if (it < C4) { const int j = it - C3; conv_tile(c.smem, c.wv, P.in[29] + (size_t)l * 1024 * 1024, c.wout(), 1024, 1024, 3, nullptr, j / 16, j % 16); }
    else if (it < C5) { const int j = it - C4; conv_tile(c.smem, c.wv, P.in[31] + (size_t)l * 1024 * FH, c.wgu(), 1024, FH, 5, nullptr, j / 44, j % 44, true); }
    else if (it < C6) { const int j = it - C5; conv_tile(c.smem, c.wv, P.in[32] + (size_t)l * 1024 * FH, c.wgu(), 1024, FH, 6, nullptr, j / 44, j % 44, true); }
    else if (it < C7) { const int j = it - C6; conv_tile(c.smem, c.wv, P.in[33] + (size_t)l * FH * 1024, c.wdn(), FH, 1024, 3, nullptr, j / 16, j % 16, true); }
    else if (it < CZ) {
      uint4 z = make_uint4(0, 0, 0, 0);
      asm volatile("" : "+v"(z.x), "+v"(z.y), "+v"(z.z), "+v"(z.w));
      uint4* d = (uint4*)(c.win() + (size_t)1696 * 1024);
      for (int i = tid; i < 96 * 1024 / 8; i += NTH) d[i] = z;
    } else if (it < CK) {
      const int j = it - CZ, g = j >> 5, t = j & 31;
      const float* ktf = c.ktab() + (size_t)((l * 16 + g) * 2 + 0) * 32 * 256;
      const float* ktb = c.ktab() + (size_t)((l * 16 + g) * 2 + 1) * 32 * 256;
      unsigned res[12];
#pragma unroll
      for (int q = 0; q < 12; ++q) {
        const int e = tid + q * NTH;
        const int cc = e / 384, k2 = (e - cc * 384) * 2;
        float v[2];
#pragma unroll
        for (int u = 0; u < 2; ++u) {
          const int k = k2 + u;
          float val;
          if (k < 512) {
            const int s = k >> 4, ci = k & 15;
            val = 0.f;
            if (s <= t) val += ktf[(t - s) * 256 + cc * 16 + ci];
            if (s >= t) val += ktb[(s - t) * 256 + cc * 16 + ci];
            if (s == t && ci == cc) val += P.in[26][l * 256 + g * 16 + cc];
          } else {
            const int kk = k - 512, dir = kk >> 7, p = (kk & 127) >> 1, ri = kk & 1;
            const int ex = dir == 0 ? t + 1 : 32 - t;
            const float2 E = c.etab()[((size_t)((l * 16 + g) * 2 + dir) * 64 + p) * 33 + ex];
            const size_t ci_ = ((size_t)((l * 2 + dir) * 16 + g) * 16 + cc) * 64 + p;
            const float cr = P.in[23][ci_], cim = P.in[24][ci_];
            val = ri == 0 ? (cr * E.x - cim * E.y) : -(cr * E.y + cim * E.x);
          }
          v[u] = val;
        }
        res[q] = pk2(v[0], v[1]);
      }
#pragma unroll
      for (int q = 0; q < 12; ++q) {
        const int e = tid + q * NTH;
        const int cc = e / 384, k2 = (e - cc * 384) * 2;
        *(unsigned*)(c.kt() + ((size_t)g * 512 + t * 16 + cc) * 768 + k2) = res[q];
      }
    } else {
      const int j = it - CK, g = j >> 4, nb = (j & 15) * 16;
      unsigned res[8];
#pragma unroll
      for (int q = 0; q < 8; ++q) {
        const int e = tid + q * NTH;
        const int rr = e >> 8, k2 = (e & 255) * 2;
        const int n = nb + rr, dir = n >> 7, p = (n & 127) >> 1, ri = n & 1;
        const int s = k2 >> 4, ci = k2 & 15;
        const int ex = dir == 0 ? 31 - s : s;
        const float2 E = c.etab()[((size_t)((l * 16 + g) * 2 + dir) * 64 + p) * 33 + ex];
        const float2 b0 = c.bbar()[((size_t)((l * 16 + g) * 2 + dir) * 64 + p) * 16 + ci];
        const float2 b1 = c.bbar()[((size_t)((l * 16 + g) * 2 + dir) * 64 + p) * 16 + ci + 1];
        const float v0 = ri == 0 ? (E.x * b0.x - E.y * b0.y) : (E.x * b0.y + E.y * b0.x);
        const float v1 = ri == 0 ? (E.x * b1.x - E.y * b1.y) : (E.x * b1.y + E.y * b1.x);
        res[q] = pk2(v0, v1);
      }
#pragma unroll
      for (int q = 0; q < 8; ++q) {
        const int e = tid + q * NTH;
        const int rr = e >> 8, k2 = (e & 255) * 2;
        *(unsigned*)(c.mint() + ((size_t)g * 256 + nb + rr) * 512 + k2) = res[q];
      }
    }
  }
}

DI int tail_slot(int total_tiles, int& stride) {
  const int lb = blockIdx.x >> 3, nlb = gridDim.x >> 3, xcd = blockIdx.x & 7;
  const int rem = total_tiles % nlb;
  if (rem == 0) { stride = (int)gridDim.x; return (int)blockIdx.x; }
  stride = 8 * (nlb - rem);
  return lb < rem ? (1 << 30) : xcd * (nlb - rem) + (lb - rem);
}

struct EpiG1 {
  const Ctx& c; int layer, m0, n0;
  DI void operator()(f32x16 (&acc)[2][4], int wm, int wn, int lane) const {
    const Params& P = c.P;
    const int r32 = lane & 31, hh = lane >> 5;
    const int nb = n0 + wn * 64, mb = m0 + wm * 128;
    const int b = seq_of(mb), Lb = seq_len(b), s0 = b * 4096;
    if (nb < 512) {
      const bool isq = nb < 256;
      const float* g = P.in[isq ? 8 : 9] + layer * 64;
      u16* dst = isq ? c.naq() : c.nak();
      const int cb = nb & 255;
      const float sc = isq ? QS_NA : 1.f;
#pragma unroll
      for (int mt = 0; mt < 4; ++mt) {
        float ss = tile_ssq(acc[0][mt]) + tile_ssq(acc[1][mt]);
        ss += lane_xor(ss, lane, 32);
        const float rstd = rsqrtf(ss * (1.f / 64.f) + RMS_EPS) * sc;
        const int tok = mb + mt * 32 + r32;
#pragma unroll
        for (int nt = 0; nt < 2; ++nt) {
          uint2 pk[4];
#pragma unroll
          for (int q4 = 0; q4 < 4; ++q4) {
            const float4 gg = *(const float4*)(g + nt * 32 + q4 * 8 + hh * 4);
            pk[q4] = pk4(acc[nt][mt][q4 * 4 + 0] * rstd * gg.x, acc[nt][mt][q4 * 4 + 1] * rstd * gg.y, acc[nt][mt][q4 * 4 + 2] * rstd * gg.z, acc[nt][mt][q4 * 4 + 3] * rstd * gg.w);
          }
          u16* d_ = dst + (size_t)tok * 256 + cb + nt * 32 + hh * 16;
          *(uint4*)d_ = make_uint4(pk[0].x, pk[0].y, pk[1].x, pk[1].y);
          *(uint4*)(d_ + 8) = make_uint4(pk[2].x, pk[2].y, pk[3].x, pk[3].y);
        }
      }
    } else if (nb < 768) {
      const int head = (nb - 512) >> 6;
#pragma unroll
      for (int mt = 0; mt < 4; ++mt) {
        const int l = mb + mt * 32 + r32 - s0;
#pragma unroll
        for (int nt = 0; nt < 2; ++nt)
#pragma unroll
          for (int i = 0; i < 16; ++i) {
            const int d = nt * 32 + (i & 3) + 8 * (i >> 2) + 4 * hh;
            c.navt()[(size_t)s0 * 256 + (size_t)(head * 64 + d) * Lb + l] = bf1(acc[nt][mt][i]);
          }
      }
    } else if (nb < 1408) {
      const bool isq = nb < 1152;
      const int cb = isq ? nb - 768 : nb - 1152;
      const int pitch = isq ? 384 : 256;
      u16* dst = isq ? c.cq() : c.ckv();
      const int slot = isq ? (cb >> 6) : 6 + (cb >> 6);
#pragma unroll
      for (int mt = 0; mt < 4; ++mt) {
        float ss = tile_ssq(acc[0][mt]) + tile_ssq(acc[1][mt]);
        ss += lane_xor(ss, lane, 32);
        const int tok = mb + mt * 32 + r32;
        if (hh == 0) c.ssq()[(size_t)tok * 16 + slot] = ss;
#pragma unroll
        for (int nt = 0; nt < 2; ++nt) {
          u16* d_ = dst + (size_t)tok * pitch + cb + nt * 32 + hh * 16;
          *(uint4*)d_ = make_uint4(pk2(acc[nt][mt][0], acc[nt][mt][1]), pk2(acc[nt][mt][2], acc[nt][mt][3]), pk2(acc[nt][mt][4], acc[nt][mt][5]), pk2(acc[nt][mt][6], acc[nt][mt][7]));
          *(uint4*)(d_ + 8) = make_uint4(pk2(acc[nt][mt][8], acc[nt][mt][9]), pk2(acc[nt][mt][10], acc[nt][mt][11]), pk2(acc[nt][mt][12], acc[nt][mt][13]), pk2(acc[nt][mt][14], acc[nt][mt][15]));
        }
      }
    } else if (nb < 1664) {
      const int cb = nb - 1408;
#pragma unroll
      for (int mt = 0; mt < 4; ++mt) {
        const int l = mb + mt * 32 + r32 - s0;
#pragma unroll
        for (int nt = 0; nt < 2; ++nt)
#pragma unroll
          for (int q4 = 0; q4 < 4; ++q4) {
            const int col = cb + nt * 32 + q4 * 8 + hh * 4;
            const int g = col >> 4, cc = col & 15;
            *(uint2*)(c.ub() + ((size_t)g * 1536 + ((s0 + l) >> 5)) * 512 + ((s0 + l) & 31) * 16 + cc) = pk4(acc[nt][mt][q4 * 4 + 0], acc[nt][mt][q4 * 4 + 1], acc[nt][mt][q4 * 4 + 2], acc[nt][mt][q4 * 4 + 3]);
          }
      }
    } else if (nb == 1664) {
      const float* g = P.in[18] + layer * 32;
#pragma unroll
      for (int mt = 0; mt < 4; ++mt) {
        float ss = tile_ssq(acc[0][mt]);
        ss += lane_xor(ss, lane, 32);
        const float rstd = rsqrtf(ss * (1.f / 32.f) + RMS_EPS);
        const int tok = mb + mt * 32 + r32, l = tok - s0;
        rope_store(acc[0][mt], rstd, g, c.rope() + (size_t)l * 32, 1.f, c.kr() + (size_t)tok * 32, hh);
      }
    }
  }
};

struct EpiQ {
  const Ctx& c; int layer, m0, n0;
  DI void operator()(f32x16 (&acc)[2][4], int wm, int wn, int lane) const {
    const Params& P = c.P;
    const int r32 = lane & 31, hh = lane >> 5;
    const int nb = n0 + wn * 64, mb = m0 + wm * 128;
    const int b = seq_of(mb), Lb = seq_len(b), s0 = b * 4096;
#pragma unroll
    for (int mt = 0; mt < 4; ++mt) {
      const int tok = mb + mt * 32 + r32, l = tok - s0;
      const float* sq = c.ssq() + (size_t)tok * 16;
      const float4 s4 = *(const float4*)sq;
      const float2 s2 = *(const float2*)(sq + 4);
      const float rc = rsqrtf((s4.x + s4.y + s4.z + s4.w + s2.x + s2.y) * (1.f / 384.f) + RMS_EPS);
      if (nb < 512) {
        const int head = nb >> 6;
        const float* g = P.in[15] + layer * 64;
        float ss = (tile_ssq(acc[0][mt]) + tile_ssq(acc[1][mt])) * rc * rc;
        ss += lane_xor(ss, lane, 32);
        const float rstd = rsqrtf(ss * (1.f / 64.f) + RMS_EPS) * rc * QS_MLA;
        u16* dst = c.qb() + (size_t)s0 * 768 + ((size_t)head * Lb + l) * 96;
#pragma unroll
        for (int nt = 0; nt < 2; ++nt) {
          uint2 pk[4];
#pragma unroll
          for (int q4 = 0; q4 < 4; ++q4) {
            const float4 gg = *(const float4*)(g + nt * 32 + q4 * 8 + hh * 4);
            pk[q4] = pk4(acc[nt][mt][q4 * 4 + 0] * rstd * gg.x, acc[nt][mt][q4 * 4 + 1] * rstd * gg.y, acc[nt][mt][q4 * 4 + 2] * rstd * gg.z, acc[nt][mt][q4 * 4 + 3] * rstd * gg.w);
          }
          u16* d_ = dst + nt * 32 + hh * 16;
          *(uint4*)d_ = make_uint4(pk[0].x, pk[0].y, pk[1].x, pk[1].y);
          *(uint4*)(d_ + 8) = make_uint4(pk[2].x, pk[2].y, pk[3].x, pk[3].y);
        }
      } else {
        const float* g = P.in[17] + layer * 32;
#pragma unroll
        for (int nt = 0; nt < 2; ++nt) {
          const int head = ((nb - 512) >> 5) + nt;
          float ss = tile_ssq(acc[nt][mt]) * rc * rc;
          ss += lane_xor(ss, lane, 32);
          const float rstd = rsqrtf(ss * (1.f / 32.f) + RMS_EPS) * rc;
          rope_store(acc[nt][mt], rstd, g, c.rope() + (size_t)l * 32, QS_MLA, c.qb() + (size_t)s0 * 768 + ((size_t)head * Lb + l) * 96 + 64, hh);
        }
      }
    }
  }
};

struct EpiKV {
  const Ctx& c; int layer, m0, n0;
  DI void operator()(f32x16 (&acc)[2][4], int wm, int wn, int lane) const {
    const Params& P = c.P;
    const int r32 = lane & 31, hh = lane >> 5;
    const int nb = n0 + wn * 64, mb = m0 + wm * 128;
    const int b = seq_of(mb), Lb = seq_len(b), s0 = b * 4096;
#pragma unroll
    for (int mt = 0; mt < 4; ++mt) {
      const int tok = mb + mt * 32 + r32, l = tok - s0;
      const float4 s4 = *(const float4*)(c.ssq() + (size_t)tok * 16 + 4);
      const float4 s5 = *(const float4*)(c.ssq() + (size_t)tok * 16 + 8);
      const float rc = rsqrtf((s4.z + s4.w + s5.x + s5.y) * (1.f / 256.f) + RMS_EPS);
      if (nb < 512) {
        const int head = nb >> 6;
        const float* g = P.in[16] + layer * 64;
        float ss = (tile_ssq(acc[0][mt]) + tile_ssq(acc[1][mt])) * rc * rc;
        ss += lane_xor(ss, lane, 32);
        const float rstd = rsqrtf(ss * (1.f / 64.f) + RMS_EPS) * rc;
        u16* dst = c.kn() + (size_t)s0 * 512 + ((size_t)head * Lb + l) * 64;
#pragma unroll
        for (int nt = 0; nt < 2; ++nt) {
          uint2 pk[4];
#pragma unroll
          for (int q4 = 0; q4 < 4; ++q4) {
            const float4 gg = *(const float4*)(g + nt * 32 + q4 * 8 + hh * 4);
            pk[q4] = pk4(acc[nt][mt][q4 * 4 + 0] * rstd * gg.x, acc[nt][mt][q4 * 4 + 1] * rstd * gg.y, acc[nt][mt][q4 * 4 + 2] * rstd * gg.z, acc[nt][mt][q4 * 4 + 3] * rstd * gg.w);
          }
          u16* d_ = dst + nt * 32 + hh * 16;
          *(uint4*)d_ = make_uint4(pk[0].x, pk[0].y, pk[1].x, pk[1].y);
          *(uint4*)(d_ + 8) = make_uint4(pk[2].x, pk[2].y, pk[3].x, pk[3].y);
        }
      } else {
        const int head = (nb - 512) >> 6;
#pragma unroll
        for (int nt = 0; nt < 2; ++nt)
#pragma unroll
          for (int i = 0; i < 16; ++i) {
            const int d = nt * 32 + (i & 3) + 8 * (i >> 2) + 4 * hh;
            c.vt()[(size_t)s0 * 512 + (size_t)(head * 64 + d) * Lb + l] = bf1(acc[nt][mt][i] * rc);
          }
      }
    }
  }
};

struct EpiSloc {
  const Ctx& c; int gc0, g, n0;
  DI void operator()(f32x16 (&acc)[2][4], int wm, int wn, int lane) const {
    const int r32 = lane & 31, hh = lane >> 5;
#pragma unroll
    for (int mt = 0; mt < 4; ++mt) {
      const int chunk = gc0 + wm * 128 + mt * 32 + r32;
      float* dst = c.sloc() + ((size_t)chunk * 16 + g) * 256 + n0 + wn * 64;
#pragma unroll
      for (int nt = 0; nt < 2; ++nt)
#pragma unroll
        for (int q4 = 0; q4 < 4; ++q4)
          *(float4*)(dst + nt * 32 + q4 * 8 + hh * 4) = make_float4(acc[nt][mt][q4 * 4 + 0], acc[nt][mt][q4 * 4 + 1], acc[nt][mt][q4 * 4 + 2], acc[nt][mt][q4 * 4 + 3]);
    }
  }
};

DI float gelu_tanh(float x) {
  const float u = 0.7978845608028654f * (x + 0.044715f * x * x * x);
  const float e = __builtin_amdgcn_exp2f(2.f * LOG2E * u);
  const float th = 1.f - 2.f * __builtin_amdgcn_rcpf(e + 1.f);
  return 0.5f * x * (1.f + th);
}

struct EpiYs {
  const Ctx& c; int gc0, g, n0;
  DI void operator()(f32x16 (&acc)[2][4], int wm, int wn, int lane) const {
    const int r32 = lane & 31, hh = lane >> 5;
#pragma unroll
    for (int mt = 0; mt < 4; ++mt) {
      const int chunk = gc0 + wm * 128 + mt * 32 + r32;
#pragma unroll
      for (int nt = 0; nt < 2; ++nt)
#pragma unroll
        for (int q4 = 0; q4 < 4; ++q4) {
          const int n = n0 + wn * 64 + nt * 32 + q4 * 8 + hh * 4;
          const int t = n >> 4, cc = n & 15;
          *(uint2*)(c.ysact() + ((size_t)chunk * 32 + t) * 256 + g * 16 + cc) =
              pk4(gelu_tanh(acc[nt][mt][q4 * 4 + 0]), gelu_tanh(acc[nt][mt][q4 * 4 + 1]), gelu_tanh(acc[nt][mt][q4 * 4 + 2]), gelu_tanh(acc[nt][mt][q4 * 4 + 3]));
        }
    }
  }
};

struct EpiGlu {
  const Ctx& c; int layer, m0, n0;
  DI void operator()(f32x16 (&acc)[2][4], int wm, int wn, int lane) const {
    const int r32 = lane & 31, hh = lane >> 5;
    const float* gb = c.P.in[28] + layer * 256;
#pragma unroll
    for (int mt = 0; mt < 4; ++mt) {
      const int tok = m0 + wm * 128 + mt * 32 + r32;
#pragma unroll
      for (int nt = 0; nt < 2; ++nt)
#pragma unroll
        for (int q4 = 0; q4 < 4; ++q4) {
          const int n = n0 + wn * 64 + nt * 32 + q4 * 8 + hh * 4;
          const float4 bb = *(const float4*)(gb + n);
          const uint2 ys = *(const uint2*)(c.ysact() + (size_t)tok * 256 + n);
          *(uint2*)(c.r1() + (size_t)tok * 1024 + 768 + n) =
              pk4(bflo(ys.x) * sigmoidf_(acc[nt][mt][q4 * 4 + 0] + bb.x), bfhi(ys.x) * sigmoidf_(acc[nt][mt][q4 * 4 + 1] + bb.y),
                  bflo(ys.y) * sigmoidf_(acc[nt][mt][q4 * 4 + 2] + bb.z), bfhi(ys.y) * sigmoidf_(acc[nt][mt][q4 * 4 + 3] + bb.w));
        }
    }
  }
};

struct EpiRes {
  const Ctx& c; int layer, m0, n0, gidx; bool from_input; int inst, ngi, nlayer, moff;
  DI void operator()(f32x16 (&acc)[2][4], int wm, int wn, int lane) const {
    const Params& P = c.P;
    const int r32 = lane & 31, hh = lane >> 5;
    const int mb = m0 + wm * 128;
    const int b = seq_of(mb);
    const float* gate = c.mod() + (size_t)(layer * 9 + b) * 6144 + gidx * 1024;
#pragma unroll
    for (int mt = 0; mt < 4; ++mt) {
      const int tok = mb + mt * 32 + r32;
      const float* xin = from_input ? (tok < TP ? P.in[0] + (size_t)tok * 1024 : P.in[1] + (size_t)(tok - TP) * 1024) : P.out + (size_t)tok * 1024;
      float* xo = P.out + (size_t)tok * 1024;
#pragma unroll
      for (int nt = 0; nt < 2; ++nt)
#pragma unroll
        for (int q4 = 0; q4 < 4; ++q4) {
          const int n = n0 + wn * 64 + nt * 32 + q4 * 8 + hh * 4;
          const float4 gg = *(const float4*)(gate + n);
          const float4 xv = *(const float4*)(xin + n);
          const float4 xn = make_float4(xv.x + gg.x * acc[nt][mt][q4 * 4 + 0], xv.y + gg.y * acc[nt][mt][q4 * 4 + 1], xv.z + gg.z * acc[nt][mt][q4 * 4 + 2], xv.w + gg.w * acc[nt][mt][q4 * 4 + 3]);
          if (inst < 0) *(float4*)(xo + n) = xn;
          acc[nt][mt][q4 * 4 + 0] = xn.x; acc[nt][mt][q4 * 4 + 1] = xn.y; acc[nt][mt][q4 * 4 + 2] = xn.z; acc[nt][mt][q4 * 4 + 3] = xn.w;
        }
    }
    if (inst < 0) return;
    float* red = (float*)(c.smem + 131072);
#pragma unroll
    for (int mt = 0; mt < 4; ++mt) {
      float ss = tile_ssq(acc[0][mt]) + tile_ssq(acc[1][mt]);
      ss += lane_xor(ss, lane, 32);
      if (hh == 0) red[(wm * 128 + mt * 32 + r32) * 4 + wn] = ss;
    }
    __syncthreads();
    const int tid = c.wv * 64 + lane;
    float* part = c.part() + (size_t)inst * TT * 4;
    unsigned* cnt = c.cnt() + inst * 192 + (m0 >> 8);
    if (tid < 256) {
      const float4 r = *(const float4*)(red + tid * 4);
      __hip_atomic_store(part + (size_t)(m0 + tid) * 4 + (n0 >> 8), r.x + r.y + r.z + r.w, __ATOMIC_RELAXED, __HIP_MEMORY_SCOPE_AGENT);
    }
    asm volatile("s_waitcnt vmcnt(0)" ::: "memory");
    __syncthreads();
    if (tid == 0) __hip_atomic_fetch_add(cnt, 1u, __ATOMIC_RELAXED, __HIP_MEMORY_SCOPE_AGENT);
#pragma unroll
    for (int mt = 0; mt < 4; ++mt) {
      float* xo = P.out + (size_t)(mb + mt * 32 + r32) * 1024;
#pragma unroll
      for (int nt = 0; nt < 2; ++nt)
#pragma unroll
        for (int q4 = 0; q4 < 4; ++q4)
          *(float4*)(xo + n0 + wn * 64 + nt * 32 + q4 * 8 + hh * 4) = make_float4(acc[nt][mt][q4 * 4 + 0], acc[nt][mt][q4 * 4 + 1], acc[nt][mt][q4 * 4 + 2], acc[nt][mt][q4 * 4 + 3]);
    }
    if (tid == 0) {
      int spins = 0;
      while (__hip_atomic_load(cnt, __ATOMIC_RELAXED, __HIP_MEMORY_SCOPE_AGENT) < 4u && ++spins < (1 << 22)) __builtin_amdgcn_s_sleep(1);
    }
    __syncthreads();
    const float* ng = P.in[ngi] + nlayer * 1024;
    const float* md = c.mod() + (size_t)(nlayer * 9 + b) * 6144 + moff;
#pragma unroll
    for (int mt = 0; mt < 4; ++mt) {
      const int tok = mb + mt * 32 + r32;
      const float* pp = part + (size_t)tok * 4;
      const float tot = __hip_atomic_load(pp, __ATOMIC_RELAXED, __HIP_MEMORY_SCOPE_AGENT) + __hip_atomic_load(pp + 1, __ATOMIC_RELAXED, __HIP_MEMORY_SCOPE_AGENT) +
                        __hip_atomic_load(pp + 2, __ATOMIC_RELAXED, __HIP_MEMORY_SCOPE_AGENT) + __hip_atomic_load(pp + 3, __ATOMIC_RELAXED, __HIP_MEMORY_SCOPE_AGENT);
      const float rstd = rsqrtf(tot * (1.f / 1024.f) + RMS_EPS);
#pragma unroll
      for (int nt = 0; nt < 2; ++nt) {
        uint2 pk[4];
#pragma unroll
        for (int q4 = 0; q4 < 4; ++q4) {
          const int n = n0 + wn * 64 + nt * 32 + q4 * 8 + hh * 4;
          const float4 gg = *(const float4*)(ng + n), sh = *(const float4*)(md + n), scl = *(const float4*)(md + 1024 + n);
          pk[q4] = pk4(acc[nt][mt][q4 * 4 + 0] * rstd * gg.x * (1.f + scl.x) + sh.x, acc[nt][mt][q4 * 4 + 1] * rstd * gg.y * (1.f + scl.y) + sh.y,
                       acc[nt][mt][q4 * 4 + 2] * rstd * gg.z * (1.f + scl.z) + sh.z, acc[nt][mt][q4 * 4 + 3] * rstd * gg.w * (1.f + scl.w) + sh.w);
        }
        u16* d = c.r1() + (size_t)tok * 1024 + n0 + wn * 64 + nt * 32 + hh * 16;
        *(uint4*)d = make_uint4(pk[0].x, pk[0].y, pk[1].x, pk[1].y);
        *(uint4*)(d + 8) = make_uint4(pk[2].x, pk[2].y, pk[3].x, pk[3].y);
      }
    }
  }
};

struct EpiSwiglu {
  const Ctx& c; int m0, n0;
  DI void operator()(f32x16 (&acc)[2][4], int wm, int wn, int lane) const {
    const int r32 = lane & 31, hh = lane >> 5;
    const int grp = (n0 + wn * 64) >> 6;
#pragma unroll
    for (int mt = 0; mt < 4; ++mt) {
      const int tok = m0 + wm * 128 + mt * 32 + r32;
      float o[16];
#pragma unroll
      for (int i = 0; i < 16; ++i) {
        const float gt = acc[0][mt][i], up = acc[1][mt][i];
        o[i] = gt * sigmoidf_(gt) * up;
      }
      u16* d = c.hid() + (size_t)tok * FH + grp * 32 + hh * 16;
      *(uint4*)d = make_uint4(pk2(o[0], o[1]), pk2(o[2], o[3]), pk2(o[4], o[5]), pk2(o[6], o[7]));
      *(uint4*)(d + 8) = make_uint4(pk2(o[8], o[9]), pk2(o[10], o[11]), pk2(o[12], o[13]), pk2(o[14], o[15]));
    }
  }
};

DI bf16x8 pack8(const f32x16& p, int s2) {
  uint4 u;
  if (s2 == 0) { u.x = pk2(p[0], p[1]); u.y = pk2(p[2], p[3]); u.z = pk2(p[4], p[5]); u.w = pk2(p[6], p[7]); }
  else { u.x = pk2(p[8], p[9]); u.y = pk2(p[10], p[11]); u.z = pk2(p[12], p[13]); u.w = pk2(p[14], p[15]); }
  return __builtin_bit_cast(bf16x8, u);
}

constexpr int KP = 104;
constexpr int VP = 136;
DI void mla_item(const Ctx& c, int b, int head, int qblk) {
  const int tid = otid(c.wv), lane = tid & 63, wave = tid >> 6;
  const int r32 = lane & 31, hh = lane >> 5;
  const int Lb = seq_len(b), s0 = b * 4096;
  u16(*Ks)[128][KP] = (u16(*)[128][KP])c.smem;
  u16(*Vs)[64][VP] = (u16(*)[64][VP])(c.smem + 2 * 128 * KP * 2);
  const u16* Q = c.qb() + (size_t)s0 * 768 + (size_t)head * Lb * 96;
  const u16* KN = c.kn() + (size_t)s0 * 512 + (size_t)head * Lb * 64;
  const u16* KR = c.kr() + (size_t)s0 * 32;
  const u16* VT = c.vt() + (size_t)s0 * 512 + (size_t)(head * 64) * Lb;
  const int q0 = qblk * 512 + wave * 64;
  bf16x8 qf[2][6];
#pragma unroll
  for (int qt = 0; qt < 2; ++qt)
#pragma unroll
    for (int ks = 0; ks < 6; ++ks) qf[qt][ks] = ldg8(Q + (size_t)(q0 + qt * 32 + r32) * 96 + ks * 16 + hh * 8);
  f32x16 o[2][2];
#pragma unroll
  for (int a = 0; a < 2; ++a)
#pragma unroll
    for (int bq = 0; bq < 2; ++bq) zero_acc(o[a][bq]);
  float lsum[2] = {0.f, 0.f};
  uint4 rk0, rk1, rk2, rv0, rv1;
  const int kkey0 = tid >> 3, kpart0 = tid & 7;
  const int kkey2 = tid >> 2, kpart2 = 8 + (tid & 3);
  const int vd0 = tid >> 4, vkc = tid & 15;
  const unsigned ko0 = kkey0 * 64 + kpart0 * 8, ko1 = ko0 + 64 * 64, ko2 = kkey2 * 32 + (tid & 3) * 8;
  const unsigned vo0 = (unsigned)vd0 * Lb + vkc * 8, vo1 = (unsigned)(vd0 + 32) * Lb + vkc * 8;
#define MGLOADK(k0_)                                       \
  {                                                        \
    const int k0__ = (k0_);                                \
    const u16* knb__ = KN + (size_t)k0__ * 64;             \
    const u16* krb__ = KR + (size_t)k0__ * 32;             \
    rk0 = *(const uint4*)(knb__ + ko0);                    \
    rk1 = *(const uint4*)(knb__ + ko1);                    \
    rk2 = *(const uint4*)(krb__ + ko2);                    \
  }
#define MGLOADV(k0_)                                       \
  {                                                        \
    const u16* vtb__ = VT + (k0_);                         \
    rv0 = *(const uint4*)(vtb__ + vo0);                    \
    rv1 = *(const uint4*)(vtb__ + vo1);                    \
  }
#define MSTOREK(buf_)                                  \
  {                                                    \
    const int b__ = (buf_);                            \
    *(uint4*)&Ks[b__][kkey0][kpart0 * 8] = rk0;        \
    *(uint4*)&Ks[b__][kkey0 + 64][kpart0 * 8] = rk1;   \
    *(uint4*)&Ks[b__][kkey2][kpart2 * 8] = rk2;        \
  }
#define MSTOREV(buf_)                                  \
  {                                                    \
    const int b__ = (buf_);                            \
    *(uint4*)&Vs[b__][vd0][vkc * 8] = rv0;             \
    *(uint4*)&Vs[b__][vd0 + 32][vkc * 8] = rv1;        \
  }
  const int ntile = Lb >> 7;
  __syncthreads();
  MGLOADK(0);
  MGLOADV(0);
  MSTOREK(0);
  MSTOREV(0);
  __syncthreads();
  const int pr = pi32(r32);
#pragma unroll 1
  for (int kt = 0; kt < ntile; ++kt) {
    const int buf = kt & 1;
    if (kt + 1 < ntile) MGLOADK((kt + 1) * 128);
#pragma unroll 2
    for (int kk = 0; kk < 4; ++kk) {
      f32x16 s[2];
      zero_acc(s[0]); zero_acc(s[1]);
#pragma unroll
      for (int ks = 0; ks < 6; ++ks) {
        const bf16x8 kf = *(const bf16x8*)&Ks[buf][kk * 32 + pr][ks * 16 + hh * 8];
        s[0] = MFMA(kf, qf[0][ks], s[0]);
        s[1] = MFMA(kf, qf[1][ks], s[1]);
      }
      bf16x8 pf[2][2];
#pragma unroll
      for (int qt = 0; qt < 2; ++qt) {
        float ls = 0.f;
#pragma unroll
        for (int i = 0; i < 16; ++i) { s[qt][i] = __builtin_amdgcn_exp2f(s[qt][i]); ls += s[qt][i]; }
        lsum[qt] += ls;
        pf[qt][0] = pack8(s[qt], 0);
        pf[qt][1] = pack8(s[qt], 1);
      }
#pragma unroll
      for (int dt = 0; dt < 2; ++dt)
#pragma unroll
        for (int s2 = 0; s2 < 2; ++s2) {
          const bf16x8 vf = *(const bf16x8*)&Vs[buf][dt * 32 + r32][kk * 32 + s2 * 16 + hh * 8];
          o[dt][0] = MFMA(vf, pf[0][s2], o[dt][0]);
          o[dt][1] = MFMA(vf, pf[1][s2], o[dt][1]);
        }
      if (kk == 1 && kt + 1 < ntile) {
        MSTOREK(buf ^ 1);
        MGLOADV((kt + 1) * 128);
      }
    }
    if (kt + 1 < ntile) MSTOREV(buf ^ 1);
    __syncthreads();
  }
#undef MGLOADK
#undef MGLOADV
#undef MSTOREK
#undef MSTOREV
  const int lane2 = otid(c.wv) & 63, r32b = lane2 & 31, hhb = lane2 >> 5;
#pragma unroll
  for (int qt = 0; qt < 2; ++qt) {
    float l = lsum[qt];
    l += lane_xor(l, lane2, 32);
    const float inv = 1.f / l;
    const int tok = b * 4096 + qblk * 512 + c.wv * 64 + qt * 32 + r32b;
    u16* dst = c.r1() + (size_t)tok * 1024 + 256 + head * 64;
#pragma unroll
    for (int dt = 0; dt < 2; ++dt)
#pragma unroll
      for (int q4 = 0; q4 < 4; ++q4)
        *(uint2*)(dst + dt * 32 + q4 * 8 + hhb * 4) = pk4(o[dt][qt][q4 * 4 + 0] * inv, o[dt][qt][q4 * 4 + 1] * inv, o[dt][qt][q4 * 4 + 2] * inv, o[dt][qt][q4 * 4 + 3] * inv);
  }
}

DI void na_item(const Ctx& c, const float* __restrict__ bias, int b, int row, int head, int qt) {
  const int lane = otid(c.wv) & 63;
  const int r32 = lane & 31, hh = lane >> 5;
  const int Lb = seq_len(b), s0 = b * 4096, rows = Lb >> 6;
  const int rstart = min(max(row - 4, 0), rows - 8);
  const int tok0 = s0 + row * 64 + qt * 32;
  bf16x8 qf[4];
#pragma unroll
  for (int ks = 0; ks < 4; ++ks) qf[ks] = ldg8(c.naq() + (size_t)(tok0 + r32) * 256 + head * 64 + ks * 16 + hh * 8);
  f32x16 o[2];
  zero_acc(o[0]); zero_acc(o[1]);
  float lsum = 0.f;
  const int pr = pi32(r32);
  const int qc = qt * 32 + r32;
  const int cs = min(max(qc - 8, 0), 48);
  const u16* VT = c.navt() + (size_t)s0 * 256 + (size_t)(head * 64) * Lb;
#pragma unroll 1
  for (int kri = 0; kri < 8; ++kri) {
    const int krow = rstart + kri;
    const float* bl = bias + (head * 15 + (krow - row + 7)) * 31;
#pragma unroll
    for (int kk = 0; kk < 2; ++kk) {
      const u16* kp = c.nak() + (size_t)(s0 + krow * 64 + kk * 32 + pr) * 256 + head * 64 + hh * 8;
      bf16x8 kf[4];
#pragma unroll
      for (int ks = 0; ks < 4; ++ks) kf[ks] = ldg8(kp + ks * 16);
      bf16x8 vf[2][2];
#pragma unroll
      for (int dt = 0; dt < 2; ++dt)
#pragma unroll
        for (int s2 = 0; s2 < 2; ++s2) vf[dt][s2] = ldg8(VT + (size_t)(dt * 32 + r32) * Lb + krow * 64 + kk * 32 + s2 * 16 + hh * 8);
      f32x16 s;
      zero_acc(s);
#pragma unroll
      for (int ks = 0; ks < 4; ++ks) s = MFMA(kf[ks], qf[ks], s);
      float ls = 0.f;
#pragma unroll
      for (int i = 0; i < 16; ++i) {
        const int kc = kk * 32 + 16 * ((i >> 3) & 1) + 8 * hh + 4 * ((i >> 2) & 1) + (i & 3);
        const bool valid = (kc >= cs) && (kc < cs + 16);
        const int bi = min(max(kc - qc + 15, 0), 30);
        const float p = valid ? __builtin_amdgcn_exp2f(s[i] + bl[bi]) : 0.f;
        s[i] = p; ls += p;
      }
      lsum += ls;
      const bf16x8 pf0 = pack8(s, 0), pf1 = pack8(s, 1);
#pragma unroll
      for (int dt = 0; dt < 2; ++dt) {
        o[dt] = MFMA(vf[dt][0], pf0, o[dt]);
        o[dt] = MFMA(vf[dt][1], pf1, o[dt]);
      }
    }
  }
  float l = lsum;
  l += lane_xor(l, lane, 32);
  const float inv = 1.f / l;
  u16* dst = c.r1() + (size_t)(tok0 + r32) * 1024 + head * 64;
#pragma unroll
  for (int dt = 0; dt < 2; ++dt)
#pragma unroll
    for (int q4 = 0; q4 < 4; ++q4)
      *(uint2*)(dst + dt * 32 + q4 * 8 + hh * 4) = pk4(o[dt][q4 * 4 + 0] * inv, o[dt][q4 * 4 + 1] * inv, o[dt][q4 * 4 + 2] * inv, o[dt][q4 * 4 + 3] * inv);
}

DI void carry_item(const Ctx& c, int layer, int it4) {
  const int tid = otid(c.wv);
  const int item = it4 * 4 + (tid >> 7);
  const int b = item >> 4, g = item & 15;
  const int dir = (tid >> 6) & 1, p = tid & 63;
  const int nch = seq_len(b) >> 5, gc0 = b * 128;
  const float2 lt = c.etab()[((size_t)((layer * 16 + g) * 2 + dir) * 64 + p) * 33 + 32];
  const float* __restrict__ sl_base = c.sloc() + (size_t)g * 256 + dir * 128 + p * 2;
  u16* __restrict__ ca_base = c.carry() + (size_t)g * 256 + dir * 128 + p * 2;
  float cr = 0.f, ci = 0.f;
  for (int k0 = 0; k0 < nch; k0 += 16) {
    float2 sl[16];
#pragma unroll
    for (int u = 0; u < 16; ++u) {
      const int ch = gc0 + (dir == 0 ? k0 + u : nch - 1 - (k0 + u));
      sl[u] = *(const float2*)(sl_base + (size_t)ch * 4096);
    }
#pragma unroll
    for (int u = 0; u < 16; ++u) {
      const int ch = gc0 + (dir == 0 ? k0 + u : nch - 1 - (k0 + u));
      *(unsigned*)(ca_base + (size_t)ch * 4096) = pk2(cr, ci);
      const float nr = lt.x * cr - lt.y * ci + sl[u].x;
      const float ni = lt.x * ci + lt.y * cr + sl[u].y;
      cr = nr; ci = ni;
    }
  }
}

template <bool COOP>
__global__ void __launch_bounds__(512, 2) mega(Params P, int ph_lo, int ph_hi, int dupmask) {
  __shared__ __attribute__((aligned(16))) unsigned char smem[2 * 2 * 256 * LP * 2];
  unsigned char* ws = P.ws;
  Ctx c{P, smem, ws, __builtin_amdgcn_readfirstlane((int)(threadIdx.x >> 6))};
  constexpr bool fuse = true;
#pragma unroll 1
  for (int ph2 = ph_lo * 2; ph2 < ph_hi * 2; ++ph2) {
    const int ph = ph2 >> 1;
    if ((ph2 & 1) && !(ph > 0 && ((dupmask >> ((ph - 1) % 10)) & 1))) continue;
    if (ph == 0) {
      phase_init(c);
    } else {
      const int l = (ph - 1) / 10, sub = (ph - 1) % 10;
      if (fuse && (sub == 7 || (sub == 0 && l > 0))) continue;
      int pg = -1, pl = 0, pstart = 0, pstride = 1;
      switch (sub) {
#if !defined(ONLY_SUB) || ONLY_SUB == 0
        case 0:
          if (l == 0) { pg = 0; pl = 0; pstart = (int)blockIdx.x; pstride = (int)gridDim.x; }
          break;
#endif
#if !defined(ONLY_SUB) || ONLY_SUB == 1
        case 1: {
          const XcdOrder xo(192, 7, 7);
          gemm_stream(smem, c.wv, xo.lb, xo.nlb, xo.total, 1024, 16,
            [&](int s) { int m, n; xo.decode(s, m, n); return TileDesc{ADesc{c.r1() + (size_t)m * 256 * 1024, 1024, nullptr, 0, 1 << 30}, c.win() + (size_t)n * 256 * 1024}; },
            [&](int s) { int m, n; xo.decode(s, m, n); return EpiG1{c, l, m * 256, n * 256}; });
          pg = 1; pl = l; pstart = tail_slot(xo.total, pstride);
        } break;
#endif
#if !defined(ONLY_SUB) || ONLY_SUB == 2
        case 2: {
          {
            const XcdOrder xo(192, 3, 3);
            gemm_stream(smem, c.wv, xo.lb, xo.nlb, xo.total, 384, 6,
              [&](int s) { int m, n; xo.decode(s, m, n); return TileDesc{ADesc{c.cq() + (size_t)m * 256 * 384, 384, nullptr, 0, 1 << 30}, c.wuq() + (size_t)n * 256 * 384}; },
              [&](int s) { int m, n; xo.decode(s, m, n); return EpiQ{c, l, m * 256, n * 256}; });
          }
          {
            const XcdOrder xo(192, 4, 4);
            gemm_stream(smem, c.wv, xo.lb, xo.nlb, xo.total, 256, 4,
              [&](int s) { int m, n; xo.decode(s, m, n); return TileDesc{ADesc{c.ckv() + (size_t)m * 256 * 256, 256, nullptr, 0, 1 << 30}, c.wukv() + (size_t)n * 256 * 256}; },
              [&](int s) { int m, n; xo.decode(s, m, n); return EpiKV{c, l, m * 256, n * 256}; });
          }
          gemm_stream(smem, c.wv, (int)blockIdx.x, (int)gridDim.x, 96, 512, 8,
            [&](int it) { const int g = it / 6, mt = it % 6; return TileDesc{ADesc{c.ub() + ((size_t)g * 1536 + mt * 256) * 512, 512, nullptr, 0, 1 << 30}, c.mint() + (size_t)g * 256 * 512}; },
            [&](int it) { const int g = it / 6, mt = it % 6; return EpiSloc{c, mt * 256, g, 0}; });
          const int tid = otid(c.wv);
          __syncthreads();
          float* bias = (float*)smem;
          for (int i = tid; i < 4 * 15 * 31; i += NTH) bias[i] = P.in[10][(size_t)l * 4 * 15 * 31 + i] * LOG2E;
          __syncthreads();
          for (int it = blockIdx.x; it < 768; it += gridDim.x) {
            int b, row;
            if (it < 512) { b = it >> 6; row = it & 63; } else { b = 8; row = it - 512; }
            na_item(c, bias, b, row, tid >> 7, (tid >> 6) & 1);
          }
          {
            const int lb = blockIdx.x >> 3, nlb = gridDim.x >> 3, xcd = blockIdx.x & 7;
            pg = 2; pl = l;
            if (nlb > 12) { pstride = 8 * (nlb - 12); pstart = lb < 12 ? (1 << 30) : xcd * (nlb - 12) + (lb - 12); }
            else { pstride = (int)gridDim.x; pstart = (int)blockIdx.x; }
          }
        } break;
#endif
#if !defined(ONLY_SUB) || ONLY_SUB == 3
        case 3: {
          for (int it = blockIdx.x; it < 36; it += gridDim.x) carry_item(c, l, it);
          for (int it = blockIdx.x; it < 768; it += gridDim.x) {
            int b, head, qblk;
            if (it < 256) { b = 8; head = it & 7; qblk = it >> 3; }
            else { const int j = it - 256; head = j & 7; b = (j >> 3) >> 3; qblk = (j >> 3) & 7; }
            mla_item(c, b, head, qblk);
          }
        } break;
#endif
#if !defined(ONLY_SUB) || ONLY_SUB == 4
        case 4:
          gemm_stream(smem, c.wv, (int)blockIdx.x, (int)gridDim.x, 192, 768, 12,
            [&](int it) { const int n = it & 1, u = it >> 1, g = u / 6, gc0 = (u % 6) * 256;
                          return TileDesc{ADesc{c.ub() + ((size_t)g * 1536 + gc0) * 512, 512, c.carry() + ((size_t)gc0 * 16 + g) * 256, 4096, 8}, c.kt() + ((size_t)g * 512 + n * 256) * 768}; },
            [&](int it) { const int n = it & 1, u = it >> 1, g = u / 6, gc0 = (u % 6) * 256; return EpiYs{c, gc0, g, n * 256}; });
          break;
#endif
#if !defined(ONLY_SUB) || ONLY_SUB == 5
        case 5: {
          const XcdOrder xo(192, 1, 1);
          gemm_stream(smem, c.wv, xo.lb, xo.nlb, xo.total, 256, 4,
            [&](int s) { int m, n; xo.decode(s, m, n); return TileDesc{ADesc{c.ysact() + (size_t)m * 256 * 256, 256, nullptr, 0, 1 << 30}, c.wglu()}; },
            [&](int s) { int m, n; xo.decode(s, m, n); return EpiGlu{c, l, m * 256, 0}; });
        } break;
#endif
#if !defined(ONLY_SUB) || ONLY_SUB == 6
        case 6: {
          const XcdOrder xo(192, 4, 4);
          gemm_stream(smem, c.wv, xo.lb, xo.nlb, xo.total, 1024, 16,
            [&](int s) { int m, n; xo.decode(s, m, n); return TileDesc{ADesc{c.r1() + (size_t)m * 256 * 1024, 1024, nullptr, 0, 1 << 30}, c.wout() + (size_t)n * 256 * 1024}; },
            [&](int s) { int m, n; xo.decode(s, m, n); return EpiRes{c, l, m * 256, n * 256, 2, l == 0, fuse ? l * 2 : -1, 30, l, 3072}; });
        } break;
#endif
#if !defined(ONLY_SUB) || ONLY_SUB == 7
        case 7: break;
#endif
#if !defined(ONLY_SUB) || ONLY_SUB == 8
        case 8: {
          const XcdOrder xo(192, 22, 11);
          gemm_stream(smem, c.wv, xo.lb, xo.nlb, xo.total, 1024, 16,
            [&](int s) { int m, n; xo.decode(s, m, n); return TileDesc{ADesc{c.r1() + (size_t)m * 256 * 1024, 1024, nullptr, 0, 1 << 30}, c.wgu() + (size_t)n * 256 * 1024}; },
            [&](int s) { int m, n; xo.decode(s, m, n); return EpiSwiglu{c, m * 256, n * 256}; });
          if (l + 1 < DEPTH) { pg = 0; pl = l + 1; pstart = tail_slot(xo.total, pstride); }
        } break;
#endif
#if !defined(ONLY_SUB) || ONLY_SUB == 9
        case 9: {
          const XcdOrder xo(192, 4, 4);
          gemm_stream(smem, c.wv, xo.lb, xo.nlb, xo.total, FH, 44,
            [&](int s) { int m, n; xo.decode(s, m, n); return TileDesc{ADesc{c.hid() + (size_t)m * 256 * FH, FH, nullptr, 0, 1 << 30}, c.wdn() + (size_t)n * 256 * FH}; },
            [&](int s) { int m, n; xo.decode(s, m, n); return EpiRes{c, l, m * 256, n * 256, 5, false, (fuse && l + 1 < DEPTH) ? l * 2 + 1 : -1, 6, l + 1, 0}; });
        } break;
#endif
      }
      if (pg >= 0) prep_items(c, pl, pg, pstart, pstride);
      if (sub == 0) norm_rows(c, 0, 0);
    }
    if (COOP) {
      if (ph2 + 1 < ph_hi * 2) cg::this_grid().sync();
    }
  }
}

extern "C" void kernel_launch(void* const* d_in, const int* in_sizes, int n_in, void* d_out, int out_size, void* d_ws, size_t ws_size, hipStream_t stream) {
  if (ws_size < O_END) { fprintf(stderr, "workspace too small: %zu < %zu\n", ws_size, (size_t)O_END); return; }
  Params p{};
  for (int i = 0; i < 34; ++i) p.in[i] = (const float*)d_in[i];
  p.out = (float*)d_out;
  p.ws = (unsigned char*)d_ws;
  static int grid_blocks = 0;
  if (!grid_blocks) {
    int dev = 0, cus = 0, per_cu = 0;
    (void)hipGetDevice(&dev);
    (void)hipDeviceGetAttribute(&cus, hipDeviceAttributeMultiprocessorCount, dev);
    (void)hipOccupancyMaxActiveBlocksPerMultiprocessor(&per_cu, mega<true>, NTH, 0);
    if (per_cu > 1) per_cu = 1;
    grid_blocks = (cus * per_cu) & ~31;
  }
  int lo = 0, hi = 41, dup = DUPMASK;
  void* args[] = {&p, &lo, &hi, &dup};
  hipError_t e = hipLaunchCooperativeKernel((void*)mega<true>, dim3(grid_blocks), dim3(NTH), args, 0, stream);
  if (e != hipSuccess) fprintf(stderr, "cooperative launch failed: %s (grid %d)\n", hipGetErrorString(e), grid_blocks);
}
```

```cpp
#include <hip/hip_runtime.h>
#include <hip/hip_cooperative_groups.h>
#include <cstdio>
#include <cstdint>
namespace cg = cooperative_groups;

typedef unsigned short u16;
typedef __attribute__((ext_vector_type(8))) short bf16x8;
typedef __attribute__((ext_vector_type(16))) float f32x16;
typedef __attribute__((ext_vector_type(2))) __bf16 bf2_t;
typedef __attribute__((ext_vector_type(2))) float f2_t;
#define DI __device__ __forceinline__
#define MFMA(a, b, c) __builtin_amdgcn_mfma_f32_32x32x16_bf16((a), (b), (c), 0, 0, 0)

#ifndef DUPMASK
#define DUPMASK 0
#endif
constexpr int NTH = 512;
constexpr int TT = 49152, TP = 32768, NSEQ = 9, DEPTH = 4, FH = 2816;
constexpr float RMS_EPS = 1e-6f;
constexpr float LOG2E = 1.4426950408889634f;
constexpr float QS_NA = 0.125f * LOG2E;
constexpr float QS_MLA = 0.10206207261596575f * LOG2E;

constexpr size_t AL(size_t x) { return (x + 255) & ~(size_t)255; }
constexpr size_t O_MOD = 0;
constexpr size_t O_ROPE = O_MOD + AL((size_t)DEPTH * NSEQ * 6144 * 4);
constexpr size_t O_ETAB = O_ROPE + AL((size_t)16384 * 32 * 4);
constexpr size_t O_BBAR = O_ETAB + AL((size_t)DEPTH * 16 * 2 * 64 * 33 * 8);
constexpr size_t O_KTAB = O_BBAR + AL((size_t)DEPTH * 16 * 2 * 64 * 16 * 8);
constexpr size_t O_SSQ = O_KTAB + AL((size_t)DEPTH * 16 * 2 * 32 * 256 * 4);
constexpr size_t O_WIN = O_SSQ + AL((size_t)TT * 16 * 4);
constexpr size_t O_WUQ = O_WIN + AL((size_t)1792 * 1024 * 2);
constexpr size_t O_WUKV = O_WUQ + AL((size_t)768 * 384 * 2);
constexpr size_t O_WGLU = O_WUKV + AL((size_t)1024 * 256 * 2);
constexpr size_t O_WOUT = O_WGLU + AL((size_t)256 * 256 * 2);
constexpr size_t O_WGU = O_WOUT + AL((size_t)1024 * 1024 * 2);
constexpr size_t O_WDN = O_WGU + AL((size_t)5632 * 1024 * 2);
constexpr size_t O_KT = O_WDN + AL((size_t)1024 * 2816 * 2);
constexpr size_t O_MINT = O_KT + AL((size_t)16 * 512 * 768 * 2);
constexpr size_t O_R1 = O_MINT + AL((size_t)16 * 256 * 512 * 2);
constexpr size_t O_SLOC = O_R1 + AL((size_t)TT * 1024 * 2);
constexpr size_t O_X = O_SLOC + AL((size_t)1536 * 16 * 256 * 4);
constexpr size_t O_NAQ = O_X;
constexpr size_t O_NAK = O_NAQ + AL((size_t)TT * 256 * 2);
constexpr size_t O_NAVT = O_NAK + AL((size_t)TT * 256 * 2);
constexpr size_t O_CQ = O_NAVT + AL((size_t)TT * 256 * 2);
constexpr size_t O_CKV = O_CQ + AL((size_t)TT * 384 * 2);
constexpr size_t O_UB = O_CKV + AL((size_t)TT * 256 * 2);
constexpr size_t O_QB = O_UB + AL((size_t)TT * 256 * 2);
constexpr size_t O_KN = O_QB + AL((size_t)TT * 768 * 2);
constexpr size_t O_KR = O_KN + AL((size_t)TT * 512 * 2);
constexpr size_t O_VT = O_KR + AL((size_t)TT * 32 * 2);
constexpr size_t O_PART = O_VT + AL((size_t)TT * 512 * 2);
constexpr size_t O_CNT = O_PART + AL((size_t)8 * TT * 4 * 4);
constexpr size_t O_END = O_CNT + AL((size_t)8 * 192 * 4);
constexpr size_t O_HID = O_X;
constexpr size_t O_CARRY = O_NAK;
constexpr size_t O_YSACT = O_NAVT;
static_assert(O_END <= (size_t)536870912, "workspace too large");
static_assert(O_HID + (size_t)TT * FH * 2 <= O_END, "hid does not fit");

struct Params { const float* in[34]; float* out; unsigned char* ws; };

DI unsigned pk2(float x, float y) { f2_t v = {x, y}; bf2_t b = __builtin_convertvector(v, bf2_t); return __builtin_bit_cast(unsigned, b); }
DI uint2 pk4(float a, float b, float c, float d) { uint2 r; r.x = pk2(a, b); r.y = pk2(c, d); return r; }
DI u16 bf1(float x) { return (u16)(pk2(x, 0.f) & 0xffffu); }
DI float bflo(unsigned v) { return __uint_as_float(v << 16); }
DI float bfhi(unsigned v) { return __uint_as_float(v & 0xffff0000u); }
DI int seq_of(int t) { return t < TP ? (t >> 12) : 8; }
DI int seq_len(int b) { return b < 8 ? 4096 : 16384; }
DI int pi32(int r) { return (r & 0x13) | ((r & 4) << 1) | ((r & 8) >> 1); }
DI float sigmoidf_(float x) { return __builtin_amdgcn_rcpf(1.f + __builtin_amdgcn_exp2f(-LOG2E * x)); }
DI float lane_xor(float v, int lane, int o) { return __int_as_float(__builtin_amdgcn_ds_bpermute((lane ^ o) << 2, __float_as_int(v))); }
DI float wave_sum(float v, int lane) {
#pragma unroll
  for (int o = 32; o >= 1; o >>= 1) v += lane_xor(v, lane, o);
  return v;
}
DI void zero_acc(f32x16& a) {
#pragma unroll
  for (int i = 0; i < 16; ++i) a[i] = 0.f;
}
DI bf16x8 ldg8(const u16* p) { return *(const bf16x8*)p; }
DI int otid(int wv) { int lane; asm volatile("v_mbcnt_lo_u32_b32 %0, -1, 0\n\tv_mbcnt_hi_u32_b32 %0, -1, %0" : "=v"(lane)); return wv * 64 + lane; }

struct ADesc { const u16* p0; long pitch0; const u16* p1; long pitch1; int ksplit; };
constexpr int LP = 72;

#define RAW_BARRIER() do { asm volatile("s_waitcnt lgkmcnt(0)" ::: "memory"); __builtin_amdgcn_s_barrier(); } while (0)
struct TileDesc { ADesc ad; const u16* bt; };

template <class DescFn, class EpiFn>
DI void gemm_stream(unsigned char* smem, const int wv, const int start, const int stride, const int end, const int ldb, const int nk, DescFn&& desc, EpiFn&& mkepi) {
  if (start >= end) return;
  const int tid = otid(wv), lane = tid & 63, wave = wv;
  const int wm = wave & 1, wn = wave >> 1;
  const int r32 = lane & 31, hh = lane >> 5;
  const bool isA = wave < 4;
  const int w3 = wave & 3;
  const int c0 = ((lane & 7) ^ (lane >> 4)) * 8, c1 = ((lane & 7) ^ (4 + (lane >> 4))) * 8;
  const int lrow = w3 * 64 + (lane >> 3);
  unsigned char* const ldst = smem + (isA ? 0 : 32768) + w3 * 8192;
#define DMA(td_, kt_, stage_)                                                                                    \
  {                                                                                                              \
    const int kt__ = (kt_);                                                                                      \
    const u16* src__; long pitch__;                                                                              \
    if (isA) {                                                                                                   \
      const bool first__ = kt__ < (td_).ad.ksplit;                                                               \
      src__ = (first__ ? (td_).ad.p0 : (td_).ad.p1) + (first__ ? kt__ : kt__ - (td_).ad.ksplit) * 64;            \
      pitch__ = first__ ? (td_).ad.pitch0 : (td_).ad.pitch1;                                                     \
    } else { src__ = (td_).bt + kt__ * 64; pitch__ = ldb; }                                                      \
    src__ += (long)lrow * pitch__;                                                                               \
    unsigned char* d__ = ldst + (stage_) * 65536;                                                                \
    _Pragma("unroll") for (int i = 0; i < 8; ++i)                                                                \
      __builtin_amdgcn_global_load_lds((const unsigned*)(src__ + (long)(i * 8) * pitch__ + ((i & 1) ? c1 : c0)), \
                                       (unsigned*)(d__ + i * 1024), 16, 0, 0);                                   \
  }
  const int sw = (r32 >> 1) & 7;
  const unsigned aoff = (unsigned)(wm * 128 + r32) * 128, boff = 32768u + (unsigned)(wn * 64 + r32) * 128;
#define LOADF(ks, S)                                                                                \
  {                                                                                                 \
    const unsigned co__ = (unsigned)((((ks) * 2 + hh) ^ sw) << 4);                                  \
    S##w0 = *(const bf16x8*)(sbase + boff + co__);                                                  \
    S##w1 = *(const bf16x8*)(sbase + boff + 32 * 128 + co__);                                       \
    S##t0 = *(const bf16x8*)(sbase + aoff + co__);                                                  \
    S##t1 = *(const bf16x8*)(sbase + aoff + 32 * 128 + co__);                                       \
    S##t2 = *(const bf16x8*)(sbase + aoff + 64 * 128 + co__);                                       \
    S##t3 = *(const bf16x8*)(sbase + aoff + 96 * 128 + co__);                                       \
  }
#define MMA(S)                                                                                      \
  {                                                                                                 \
    acc[0][0] = MFMA(S##w0, S##t0, acc[0][0]);                                                      \
    acc[1][0] = MFMA(S##w1, S##t0, acc[1][0]);                                                      \
    acc[0][1] = MFMA(S##w0, S##t1, acc[0][1]);                                                      \
    acc[1][1] = MFMA(S##w1, S##t1, acc[1][1]);                                                      \
    acc[0][2] = MFMA(S##w0, S##t2, acc[0][2]);                                                      \
    acc[1][2] = MFMA(S##w1, S##t2, acc[1][2]);                                                      \
    acc[0][3] = MFMA(S##w0, S##t3, acc[0][3]);                                                      \
    acc[1][3] = MFMA(S##w1, S##t3, acc[1][3]);                                                      \
  }
  int cur_i = start;
  TileDesc cur = desc(cur_i);
  DMA(cur, 0, 0);
#pragma unroll 1
  while (true) {
    const int nxt_i = cur_i + stride;
    const bool has_next = nxt_i < end;
    TileDesc nxt = cur;
    if (has_next) nxt = desc(nxt_i);
    f32x16 acc[2][4];
#pragma unroll
    for (int a = 0; a < 2; ++a)
#pragma unroll
      for (int b = 0; b < 4; ++b) zero_acc(acc[a][b]);
    bf16x8 Fw0, Fw1, Ft0, Ft1, Ft2, Ft3, Gw0, Gw1, Gt0, Gt1, Gt2, Gt3;
#pragma unroll 1
    for (int kt = 0; kt < nk; ++kt) {
      const int buf = kt & 1;
      asm volatile("s_waitcnt vmcnt(0)" ::: "memory");
      RAW_BARRIER();
      if (wave < 4) {
        if (kt + 1 < nk) { DMA(cur, kt + 1, buf ^ 1); }
        else if (has_next) { DMA(nxt, 0, 0); }
      }
      const unsigned char* sbase = smem + buf * 65536;
      LOADF(0, F);
      LOADF(1, G);
      MMA(F);
      if (wave >= 4) {
        if (kt + 1 < nk) { DMA(cur, kt + 1, buf ^ 1); }
        else if (has_next) { DMA(nxt, 0, 0); }
      }
      MMA(G);
      LOADF(2, F);
      LOADF(3, G);
      MMA(F);
      MMA(G);
    }
    mkepi(cur_i)(acc, wm, wn, lane);
    if (!has_next) break;
    cur = nxt;
    cur_i = nxt_i;
  }
  asm volatile("s_waitcnt vmcnt(0)" ::: "memory");
  RAW_BARRIER();
#undef LOADF
#undef MMA
#undef DMA
}

struct XcdOrder {
  int xcd, lb, nlb, mper, NG, total;
  DI XcdOrder(int MT, int NT, int NG_) { xcd = blockIdx.x & 7; lb = blockIdx.x >> 3; nlb = gridDim.x >> 3; mper = MT >> 3; NG = NG_; total = mper * NT; }
  DI void decode(int s, int& m, int& n) const {
    const int grp = s / (mper * NG), rem = s - grp * (mper * NG);
    m = xcd * mper + rem / NG; n = grp * NG + rem % NG;
  }
};

DI void rope_store(const f32x16& a, float rstd, const float* __restrict__ g, const float* __restrict__ ropel, float sc, u16* dst, int hh) {
  uint2 pk[4];
#pragma unroll
  for (int q4 = 0; q4 < 2; ++q4) {
    const int j0 = 8 * q4 + 4 * hh;
    const float4 g1 = *(const float4*)(g + j0), g2 = *(const float4*)(g + 16 + j0);
    const float4 c = *(const float4*)(ropel + j0), s = *(const float4*)(ropel + 16 + j0);
    const float x1[4] = {a[q4 * 4 + 0] * rstd * g1.x, a[q4 * 4 + 1] * rstd * g1.y, a[q4 * 4 + 2] * rstd * g1.z, a[q4 * 4 + 3] * rstd * g1.w};
    const float x2[4] = {a[q4 * 4 + 8] * rstd * g2.x, a[q4 * 4 + 9] * rstd * g2.y, a[q4 * 4 + 10] * rstd * g2.z, a[q4 * 4 + 11] * rstd * g2.w};
    const float cc[4] = {c.x, c.y, c.z, c.w}, ss[4] = {s.x, s.y, s.z, s.w};
    float o1[4], o2[4];
#pragma unroll
    for (int j = 0; j < 4; ++j) { o1[j] = (x1[j] * cc[j] - x2[j] * ss[j]) * sc; o2[j] = (x1[j] * ss[j] + x2[j] * cc[j]) * sc; }
    pk[q4] = pk4(o1[0], o1[1], o1[2], o1[3]);
    pk[2 + q4] = pk4(o2[0], o2[1], o2[2], o2[3]);
  }
  *(uint4*)(dst + hh * 16) = make_uint4(pk[0].x, pk[0].y, pk[1].x, pk[1].y);
  *(uint4*)(dst + hh * 16 + 8) = make_uint4(pk[2].x, pk[2].y, pk[3].x, pk[3].y);
}

DI float tile_ssq(const f32x16& a) {
  float s = 0.f;
#pragma unroll
  for (int i = 0; i < 16; ++i) s += a[i] * a[i];
  return s;
}

struct Ctx {
  const Params& P;
  unsigned char* smem;
  unsigned char* ws;
  int wv;
  DI float* mod() const { return (float*)(ws + O_MOD); }
  DI float* rope() const { return (float*)(ws + O_ROPE); }
  DI float* ssq() const { return (float*)(ws + O_SSQ); }
  DI float* sloc() const { return (float*)(ws + O_SLOC); }
  DI float* ktab() const { return (float*)(ws + O_KTAB); }
  DI float* part() const { return (float*)(ws + O_PART); }
  DI unsigned* cnt() const { return (unsigned*)(ws + O_CNT); }
  DI float2* etab() const { return (float2*)(ws + O_ETAB); }
  DI float2* bbar() const { return (float2*)(ws + O_BBAR); }
  DI u16* win() const { return (u16*)(ws + O_WIN); }
  DI u16* wuq() const { return (u16*)(ws + O_WUQ); }
  DI u16* wukv() const { return (u16*)(ws + O_WUKV); }
  DI u16* wglu() const { return (u16*)(ws + O_WGLU); }
  DI u16* wout() const { return (u16*)(ws + O_WOUT); }
  DI u16* wgu() const { return (u16*)(ws + O_WGU); }
  DI u16* wdn() const { return (u16*)(ws + O_WDN); }
  DI u16* kt() const { return (u16*)(ws + O_KT); }
  DI u16* mint() const { return (u16*)(ws + O_MINT); }
  DI u16* r1() const { return (u16*)(ws + O_R1); }
  DI u16* naq() const { return (u16*)(ws + O_NAQ); }
  DI u16* nak() const { return (u16*)(ws + O_NAK); }
  DI u16* navt() const { return (u16*)(ws + O_NAVT); }
  DI u16* cq() const { return (u16*)(ws + O_CQ); }
  DI u16* ckv() const { return (u16*)(ws + O_CKV); }
  DI u16* ub() const { return (u16*)(ws + O_UB); }
  DI u16* qb() const { return (u16*)(ws + O_QB); }
  DI u16* kn() const { return (u16*)(ws + O_KN); }
  DI u16* kr() const { return (u16*)(ws + O_KR); }
  DI u16* vt() const { return (u16*)(ws + O_VT); }
  DI u16* hid() const { return (u16*)(ws + O_HID); }
  DI u16* carry() const { return (u16*)(ws + O_CARRY); }
  DI u16* ysact() const { return (u16*)(ws + O_YSACT); }
};

__device__ const double INV_FREQ_TURNS[16] = {1.59154943091895346e-01, 8.94994016088910133e-02, 5.03292121044870353e-02, 2.83021958306233987e-02,
                                              1.59154943091895339e-02, 8.94994016088910237e-03, 5.03292121044870370e-03, 2.83021958306233987e-03,
                                              1.59154943091895356e-03, 8.94994016088910237e-04, 5.03292121044870326e-04, 2.83021958306233954e-04,
                                              1.59154943091895351e-04, 8.94994016088910182e-05, 5.03292121044870354e-05, 2.83021958306233961e-05};

DI void phase_init(const Ctx& c) {
  const Params& P = c.P;
  const int tid = otid(c.wv);
  if (blockIdx.x == 0) for (int i = tid; i < 8 * 192; i += NTH) c.cnt()[i] = 0u;
  for (int it = blockIdx.x; it < 640; it += gridDim.x) {
    __syncthreads();
    if (it < 384) {
      const int l = it / 96, n0 = (it % 96) * 64;
      float* sc = (float*)c.smem;
      float* red = sc + 9 * 1024;
      for (int i = tid; i < 9 * 1024; i += NTH) {
        const int b = i >> 10, k = i & 1023;
        const float v = b < 8 ? P.in[2][b * 1024 + k] : P.in[3][k];
        sc[i] = v / (1.f + __expf(-v));
      }
      __syncthreads();
      const int col = tid & 63, kq = tid >> 6;
      float acc[9];
#pragma unroll
      for (int b = 0; b < 9; ++b) acc[b] = 0.f;
      const float* w = P.in[4] + (size_t)l * 1024 * 6144 + n0 + col;
      for (int k = kq * 128; k < kq * 128 + 128; ++k) {
        const float wv = w[(size_t)k * 6144];
#pragma unroll
        for (int b = 0; b < 9; ++b) acc[b] += sc[b * 1024 + k] * wv;
      }
#pragma unroll
      for (int b = 0; b < 9; ++b) red[(kq * 9 + b) * 64 + col] = acc[b];
      __syncthreads();
      for (int i = tid; i < 9 * 64; i += NTH) {
        const int b = i >> 6, cc = i & 63;
        float v = 0.f;
#pragma unroll
        for (int q = 0; q < 8; ++q) v += red[(q * 9 + b) * 64 + cc];
        c.mod()[(size_t)(l * 9 + b) * 6144 + n0 + cc] = v + P.in[5][l * 6144 + n0 + cc];
      }
    } else if (it < 512) {
      const int base = (it - 384) * 2048;
      for (int i = tid; i < 2048; i += NTH) {
        const int idx = base + i, pos = idx >> 4, j = idx & 15;
        double t = (double)pos * INV_FREQ_TURNS[j];
        t -= __builtin_rint(t);
        const float tf = (float)t;
        c.rope()[pos * 32 + j] = __builtin_amdgcn_cosf(tf);
        c.rope()[pos * 32 + 16 + j] = __builtin_amdgcn_sinf(tf);
      }
    } else {
      const int id = it - 512, l = id >> 5, g = (id >> 1) & 15, dir = id & 1;
      float* Ere = (float*)c.smem;
      float* Eim = Ere + 64 * 33;
      float* Bre = Eim + 64 * 33;
      float* Bim = Bre + 64 * 16;
      const int ag = (l * 2 + dir) * 16 + g;
      const float dt = __expf(P.in[25][ag]);
      for (int i = tid; i < 64 * 33; i += NTH) {
        const int p = i / 33, d = i - p * 33;
        const float are = P.in[19][ag * 64 + p], aim = P.in[20][ag * 64 + p];
        const float mag = __expf(are * dt * (float)d);
        double t = (double)aim * (double)dt * (double)d * 0.15915494309189535;
        t -= __builtin_rint(t);
        const float tf = (float)t;
        const float er = mag * __builtin_amdgcn_cosf(tf), ei = mag * __builtin_amdgcn_sinf(tf);
        Ere[i] = er; Eim[i] = ei;
        c.etab()[(size_t)((l * 16 + g) * 2 + dir) * 64 * 33 + i] = make_float2(er, ei);
      }
      for (int i = tid; i < 64 * 16; i += NTH) {
        const int p = i >> 4, cc = i & 15;
        const float are = P.in[19][ag * 64 + p], aim = P.in[20][ag * 64 + p];
        const float xr = are * dt;
        double t = (double)aim * (double)dt * 0.15915494309189535;
        t -= __builtin_rint(t);
        const float tf = (float)t;
        const float cs = __builtin_amdgcn_cosf(tf), sn = __builtin_amdgcn_sinf(tf), sh = __builtin_amdgcn_sinf(0.5f * tf);
        const float em1 = expm1f(xr);
        const float nr = em1 * cs - 2.f * sh * sh, ni = (em1 + 1.f) * sn;
        const float den = 1.f / (are * are + aim * aim);
        const float qr = (nr * are + ni * aim) * den, qi = (ni * are - nr * aim) * den;
        const float br = P.in[21][(size_t)(ag * 64 + p) * 16 + cc], bi = P.in[22][(size_t)(ag * 64 + p) * 16 + cc];
        const float rr = qr * br - qi * bi, ri = qr * bi + qi * br;
        Bre[i] = rr; Bim[i] = ri;
        c.bbar()[(size_t)(((l * 16 + g) * 2 + dir) * 64) * 16 + i] = make_float2(rr, ri);
      }
      __syncthreads();
      {
        const int pr_ = tid & 255, dh = tid >> 8;
        const int co = pr_ >> 4, ci = pr_ & 15;
        float acc[16];
#pragma unroll
        for (int d = 0; d < 16; ++d) acc[d] = 0.f;
        const float* cre = P.in[23] + (size_t)(ag * 16 + co) * 64;
        const float* cim = P.in[24] + (size_t)(ag * 16 + co) * 64;
        for (int p = 0; p < 64; ++p) {
          const float cr = cre[p], cim_ = cim[p];
          const float br = Bre[p * 16 + ci], bi = Bim[p * 16 + ci];
          const float gr = cr * br - cim_ * bi, gi = cr * bi + cim_ * br;
#pragma unroll
          for (int d = 0; d < 16; ++d) acc[d] += gr * Ere[p * 33 + dh * 16 + d] - gi * Eim[p * 33 + dh * 16 + d];
        }
#pragma unroll
        for (int d = 0; d < 16; ++d) c.ktab()[((size_t)(((l * 16 + g) * 2 + dir) * 32 + dh * 16 + d)) * 256 + pr_] = acc[d];
      }
    }
  }
}

DI int perm_col(int kind, int n) {
  switch (kind) {
    case 0: return n < 1408 ? n : (n < 1440 ? n - 1408 + 1664 : n - 1440 + 1408);
    case 1: { const int h = n / 96, j = n - h * 96; return j < 64 ? h * 64 + j : 512 + h * 32 + (j - 64); }
    case 2: { const int h = n >> 7, j = n & 127; return j < 64 ? h * 64 + j : 512 + h * 64 + (j - 64); }
    case 5: return (n >> 5) * 64 + (n & 31);
    case 6: return (n >> 5) * 64 + 32 + (n & 31);
    default: return n;
  }
}

DI void conv_tile(unsigned char* smem, const int wv, const float* __restrict__ src, u16* __restrict__ dst, int K, int N, int kind, const float* __restrict__ gain, int ktile, int ntile, bool kperm = false) {
  u16(*T)[LP] = (u16(*)[LP])smem;
  const int tid = otid(wv);
  const int nl = tid & 63, kq = tid >> 6;
  const int n = ntile * 64 + nl, k0 = ktile * 64;
  __syncthreads();
#pragma unroll 4
  for (int i = 0; i < 8; ++i) {
    const int k = kq * 8 + i;
    float v = 0.f;
    if (n < N) { v = src[(size_t)(k0 + k) * N + n]; if (gain) v *= gain[k0 + k]; }
    T[nl][k] = bf1(v);
  }
  __syncthreads();
  const int row = tid >> 3, seg = tid & 7;
  const int nn = ntile * 64 + row;
  if (nn < N) {
    const int dr = perm_col(kind, nn);
    uint4 v0;
    if (kperm) {
      const int base = (seg >> 2) * 32 + (seg & 1) * 16 + ((seg >> 1) & 1) * 4;
      const uint2 lo = *(const uint2*)&T[row][base], hi = *(const uint2*)&T[row][base + 8];
      v0 = make_uint4(lo.x, lo.y, hi.x, hi.y);
    } else {
      v0 = *(const uint4*)&T[row][seg * 8];
    }
    *(uint4*)(dst + (size_t)dr * K + k0 + seg * 8) = v0;
  }
}

DI void norm_rows(const Ctx& c, int layer, int which) {
  const Params& P = c.P;
  const int tid_ = otid(c.wv);
  const int lane = tid_ & 63, wave = tid_ >> 6;
  const float* g = P.in[which ? 30 : 6] + layer * 1024;
  for (int tok0 = (blockIdx.x * 8 + wave) * 2; tok0 < TT; tok0 += gridDim.x * 16) {
    float4 v[2][4];
    float ss[2] = {0.f, 0.f};
#pragma unroll
    for (int t = 0; t < 2; ++t) {
      const int tok = tok0 + t;
      const float* x;
      if (layer == 0 && which == 0) x = tok < TP ? P.in[0] + (size_t)tok * 1024 : P.in[1] + (size_t)(tok - TP) * 1024;
      else x = P.out + (size_t)tok * 1024;
#pragma unroll
      for (int j = 0; j < 4; ++j) v[t][j] = *(const float4*)(x + j * 256 + lane * 4);
    }
#pragma unroll
    for (int t = 0; t < 2; ++t) {
#pragma unroll
      for (int j = 0; j < 4; ++j) ss[t] += v[t][j].x * v[t][j].x + v[t][j].y * v[t][j].y + v[t][j].z * v[t][j].z + v[t][j].w * v[t][j].w;
      ss[t] = wave_sum(ss[t], lane);
    }
    const int b = seq_of(tok0);
    const float* md = c.mod() + (size_t)(layer * 9 + b) * 6144 + (which ? 3072 : 0);
#pragma unroll
    for (int j = 0; j < 4; ++j) {
      const int idx = j * 256 + lane * 4;
      const float4 gg = *(const float4*)(g + idx), sh = *(const float4*)(md + idx), scl = *(const float4*)(md + 1024 + idx);
#pragma unroll
      for (int t = 0; t < 2; ++t) {
        const float rstd = rsqrtf(ss[t] * (1.f / 1024.f) + RMS_EPS);
        const float o0 = v[t][j].x * rstd * gg.x * (1.f + scl.x) + sh.x;
        const float o1 = v[t][j].y * rstd * gg.y * (1.f + scl.y) + sh.y;
        const float o2 = v[t][j].z * rstd * gg.z * (1.f + scl.z) + sh.z;
        const float o3 = v[t][j].w * rstd * gg.w * (1.f + scl.w) + sh.w;
        *(uint2*)(c.r1() + (size_t)(tok0 + t) * 1024 + ((idx & ~31) + ((idx >> 2) & 1) * 16 + ((idx >> 3) & 3) * 4)) = pk4(o0, o1, o2, o3);
      }
    }
  }
}

constexpr int PREP_NA = 825, PREP_NB = 784, PREP_NC = 2112;
DI void prep_items(const Ctx& c, int l, int group, int start, int stride) {
  const Params& P = c.P;
  const int tid = otid(c.wv);
  constexpr int C0 = 432, C1 = C0 + 72, C2 = C1 + 64, C3 = C2 + 16, C4 = C3 + 256, C5 = C4 + 704, C6 = C5 + 704, C7 = C6 + 704;
  constexpr int CZ = C7 + 1, CK = CZ + 512, CM = CK + 256;
  static_assert(C2 + 1 + (CM - CK) == PREP_NA && (C4 - C2) + (CK - CZ) == PREP_NB && (C7 - C4) == PREP_NC, "prep item counts");
  const int nitems = group == 0 ? PREP_NA : (group == 1 ? PREP_NB : PREP_NC);
  for (int gi = start; gi < nitems; gi += stride) {
    int it;
    if (group == 0) it = gi < C2 ? gi : (gi == C2 ? C7 : CK + (gi - C2 - 1));
    else if (group == 1) it = gi < (C4 - C2) ? C2 + gi : CZ + (gi - (C4 - C2));
    else it = C4 + gi;
    if (it < C0) conv_tile(c.smem, c.wv, P.in[7] + (size_t)l * 1024 * 1696, c.win(), 1024, 1696, 0, nullptr, it / 27, it % 27, true);
    else if (it < C1) { const int j = it - C0; conv_tile(c.smem, c.wv, P.in[13] + (size_t)l * 384 * 768, c.wuq(), 384, 768, 1, P.in[11] + l * 384, j / 12, j % 12, true); }
    else if (it < C2) { const int j = it - C1; conv_tile(c.smem, c.wv, P.in[14] + (size_t)l * 256 * 1024, c.wukv(), 256, 1024, 2, P.in[12] + l * 256, j / 16, j % 16, true); }
    else if (it < C3) { const int j = it - C2; conv_tile(c.smem, c.wv, P.in[27] + (size_t)l * 256 * 256, c.wglu(), 256, 256, 3, nullptr, j / 4, j % 4); }
    else if (it < C4) { const int j = it - C3; conv_tile(c.smem, c.wv, P.in[29] + (size_t)l * 1024 * 1024, c.wout(), 1024, 1024, 3, nullptr, j / 16, j % 16, true); }
    else if (it < C5) { const int j = it - C4; conv_tile(c.smem, c.wv, P.in[31] + (size_t)l * 1024 * FH, c.wgu(), 1024, FH, 5, nullptr, j / 44, j % 44, true); }
    else if (it < C6) { const int j = it - C5; conv_tile(c.smem, c.wv, P.in[32] + (size_t)l * 1024 * FH, c.wgu(), 1024, FH, 6, nullptr, j / 44, j % 44, true); }
    else if (it < C7) { const int j = it - C6; conv_tile(c.smem, c.wv, P.in[33] + (size_t)l * FH * 1024, c.wdn(), FH, 1024, 3, nullptr, j / 16, j % 16, true); }
    else if (it < CZ) {
      uint4 z = make_uint4(0, 0, 0, 0);
      asm volatile("" : "+v"(z.x), "+v"(z.y), "+v"(z.z), "+v"(z.w));
      uint4* d = (uint4*)(c.win() + (size_t)1696 * 1024);
      for (int i = tid; i < 96 * 1024 / 8; i += NTH) d[i] = z;
    } else if (it < CK) {
      const int j = it - CZ, g = j >> 5, t = j & 31;
      const float* ktf = c.ktab() + (size_t)((l * 16 + g) * 2 + 0) * 32 * 256;
      const float* ktb = c.ktab() + (size_t)((l * 16 + g) * 2 + 1) * 32 * 256;
      unsigned res[12];
#pragma unroll
      for (int q = 0; q < 12; ++q) {
        const int e = tid + q * NTH;
        const int cc = e / 384, k2 = (e - cc * 384) * 2;
        float v[2];
#pragma unroll
        for (int u = 0; u < 2; ++u) {
          const int k = k2 + u;
          float val;
          if (k < 512) {
            const int s = k >> 4, ci = k & 15;
            val = 0.f;
            if (s <= t) val += ktf[(t - s) * 256 + cc * 16 + ci];
            if (s >= t) val += ktb[(s - t) * 256 + cc * 16 + ci];
            if (s == t && ci == cc) val += P.in[26][l * 256 + g * 16 + cc];
          } else {
            const int kk = k - 512, dir = kk >> 7, p = (kk & 127) >> 1, ri = kk & 1;
            const int ex = dir == 0 ? t + 1 : 32 - t;
            const float2 E = c.etab()[((size_t)((l * 16 + g) * 2 + dir) * 64 + p) * 33 + ex];
            const size_t ci_ = ((size_t)((l * 2 + dir) * 16 + g) * 16 + cc) * 64 + p;
            const float cr = P.in[23][ci_], cim = P.in[24][ci_];
            val = ri == 0 ? (cr * E.x - cim * E.y) : -(cr * E.y + cim * E.x);
          }
          v[u] = val;
        }
        res[q] = pk2(v[0], v[1]);
      }
#pragma unroll
      for (int q = 0; q < 12; ++q) {
        const int e = tid + q * NTH;
        const int cc = e / 384, k2 = (e - cc * 384) * 2;
        *(unsigned*)(c.kt() + ((size_t)g * 512 + t * 16 + cc) * 768 + k2) = res[q];
      }
    } else {
      const int j = it - CK, g = j >> 4, nb = (j & 15) * 16;
      unsigned res[8];
#pragma unroll
      for (int q = 0; q < 8; ++q) {
        const int e = tid + q * NTH;
        const int rr = e >> 8, k2 = (e & 255) * 2;
        const int n = nb + rr, dir = n >> 7, p = (n & 127) >> 1, ri = n & 1;
        const int s = k2 >> 4, ci = k2 & 15;
        const int ex = dir == 0 ? 31 - s : s;
        const float2 E = c.etab()[((size_t)((l * 16 + g) * 2 + dir) * 64 + p) * 33 + ex];
        const float2 b0 = c.bbar()[((size_t)((l * 16 + g) * 2 + dir) * 64 + p) * 16 + ci];
        const float2 b1 = c.bbar()[((size_t)((l * 16 + g) * 2 + dir) * 64 + p) * 16 + ci + 1];
        const float v0 = ri == 0 ? (E.x * b0.x - E.y * b0.y) : (E.x * b0.y + E.y * b0.x);
        const float v1 = ri == 0 ? (E.x * b1.x - E.y * b1.y) : (E.x * b1.y + E.y * b1.x);
        res[q] = pk2(v0, v1);
      }
#pragma unroll
      for (int q = 0; q < 8; ++q) {
        const int e = tid + q * NTH;
        const int rr = e >> 8, k2 = (e & 255) * 2;
        *(unsigned*)(c.mint() + ((size_t)g * 256 + nb + rr) * 512 + k2) = res[q];
      }
    }
  }
}

DI int tail_slot(int total_tiles, int& stride) {
  const int lb = blockIdx.x >> 3, nlb = gridDim.x >> 3, xcd = blockIdx.x & 7;
  const int rem = total_tiles % nlb;
  if (rem == 0) { stride = (int)gridDim.x; return (int)blockIdx.x; }
  stride = 8 * (nlb - rem);
  return lb < rem ? (1 << 30) : xcd * (nlb - rem) + (lb - rem);
}

struct EpiG1 {
  const Ctx& c; int layer, m0, n0;
  DI void operator()(f32x16 (&acc)[2][4], int wm, int wn, int lane) const {
    const Params& P = c.P;
    const int r32 = lane & 31, hh = lane >> 5;
    const int nb = n0 + wn * 64, mb = m0 + wm * 128;
    const int b = seq_of(mb), Lb = seq_len(b), s0 = b * 4096;
    if (nb < 512) {
      const bool isq = nb < 256;
      const float* g = P.in[isq ? 8 : 9] + layer * 64;
      u16* dst = isq ? c.naq() : c.nak();
      const int cb = nb & 255;
      const float sc = isq ? QS_NA : 1.f;
#pragma unroll
      for (int mt = 0; mt < 4; ++mt) {
        float ss = tile_ssq(acc[0][mt]) + tile_ssq(acc[1][mt]);
        ss += lane_xor(ss, lane, 32);
        const float rstd = rsqrtf(ss * (1.f / 64.f) + RMS_EPS) * sc;
        const int tok = mb + mt * 32 + r32;
#pragma unroll
        for (int nt = 0; nt < 2; ++nt) {
          uint2 pk[4];
#pragma unroll
          for (int q4 = 0; q4 < 4; ++q4) {
            const float4 gg = *(const float4*)(g + nt * 32 + q4 * 8 + hh * 4);
            pk[q4] = pk4(acc[nt][mt][q4 * 4 + 0] * rstd * gg.x, acc[nt][mt][q4 * 4 + 1] * rstd * gg.y, acc[nt][mt][q4 * 4 + 2] * rstd * gg.z, acc[nt][mt][q4 * 4 + 3] * rstd * gg.w);
          }
          u16* d_ = dst + (size_t)tok * 256 + cb + nt * 32 + hh * 16;
          *(uint4*)d_ = make_uint4(pk[0].x, pk[0].y, pk[1].x, pk[1].y);
          *(uint4*)(d_ + 8) = make_uint4(pk[2].x, pk[2].y, pk[3].x, pk[3].y);
        }
      }
    } else if (nb < 768) {
      const int head = (nb - 512) >> 6;
#pragma unroll
      for (int mt = 0; mt < 4; ++mt) {
        const int l = mb + mt * 32 + r32 - s0;
#pragma unroll
        for (int nt = 0; nt < 2; ++nt)
#pragma unroll
          for (int i = 0; i < 16; ++i) {
            const int d = nt * 32 + (i & 3) + 8 * (i >> 2) + 4 * hh;
            c.navt()[(size_t)s0 * 256 + (size_t)(head * 64 + d) * Lb + l] = bf1(acc[nt][mt][i]);
          }
      }
    } else if (nb < 1408) {
      const bool isq = nb < 1152;
      const int cb = isq ? nb - 768 : nb - 1152;
      const int pitch = isq ? 384 : 256;
      u16* dst = isq ? c.cq() : c.ckv();
      const int slot = isq ? (cb >> 6) : 6 + (cb >> 6);
#pragma unroll
      for (int mt = 0; mt < 4; ++mt) {
        float ss = tile_ssq(acc[0][mt]) + tile_ssq(acc[1][mt]);
        ss += lane_xor(ss, lane, 32);
        const int tok = mb + mt * 32 + r32;
        if (hh == 0) c.ssq()[(size_t)tok * 16 + slot] = ss;
#pragma unroll
        for (int nt = 0; nt < 2; ++nt) {
          u16* d_ = dst + (size_t)tok * pitch + cb + nt * 32 + hh * 16;
          *(uint4*)d_ = make_uint4(pk2(acc[nt][mt][0], acc[nt][mt][1]), pk2(acc[nt][mt][2], acc[nt][mt][3]), pk2(acc[nt][mt][4], acc[nt][mt][5]), pk2(acc[nt][mt][6], acc[nt][mt][7]));
          *(uint4*)(d_ + 8) = make_uint4(pk2(acc[nt][mt][8], acc[nt][mt][9]), pk2(acc[nt][mt][10], acc[nt][mt][11]), pk2(acc[nt][mt][12], acc[nt][mt][13]), pk2(acc[nt][mt][14], acc[nt][mt][15]));
        }
      }
    } else if (nb < 1664) {
      const int cb = nb - 1408;
#pragma unroll
      for (int mt = 0; mt < 4; ++mt) {
        const int l = mb + mt * 32 + r32 - s0;
#pragma unroll
        for (int nt = 0; nt < 2; ++nt)
#pragma unroll
          for (int q4 = 0; q4 < 4; ++q4) {
            const int col = cb + nt * 32 + q4 * 8 + hh * 4;
            const int g = col >> 4, cc = col & 15;
            *(uint2*)(c.ub() + ((size_t)g * 1536 + ((s0 + l) >> 5)) * 512 + ((s0 + l) & 31) * 16 + cc) = pk4(acc[nt][mt][q4 * 4 + 0], acc[nt][mt][q4 * 4 + 1], acc[nt][mt][q4 * 4 + 2], acc[nt][mt][q4 * 4 + 3]);
          }
      }
    } else if (nb == 1664) {
      const float* g = P.in[18] + layer * 32;
#pragma unroll
      for (int mt = 0; mt < 4; ++mt) {
        float ss = tile_ssq(acc[0][mt]);
        ss += lane_xor(ss, lane, 32);
        const float rstd = rsqrtf(ss * (1.f / 32.f) + RMS_EPS);
        const int tok = mb + mt * 32 + r32, l = tok - s0;
        rope_store(acc[0][mt], rstd, g, c.rope() + (size_t)l * 32, 1.f, c.kr() + (size_t)tok * 32, hh);
      }
    }
  }
};

struct EpiQ {
  const Ctx& c; int layer, m0, n0;
  DI void operator()(f32x16 (&acc)[2][4], int wm, int wn, int lane) const {
    const Params& P = c.P;
    const int r32 = lane & 31, hh = lane >> 5;
    const int nb = n0 + wn * 64, mb = m0 + wm * 128;
    const int b = seq_of(mb), Lb = seq_len(b), s0 = b * 4096;
#pragma unroll
    for (int mt = 0; mt < 4; ++mt) {
      const int tok = mb + mt * 32 + r32, l = tok - s0;
      const float* sq = c.ssq() + (size_t)tok * 16;
      const float4 s4 = *(const float4*)sq;
      const float2 s2 = *(const float2*)(sq + 4);
      const float rc = rsqrtf((s4.x + s4.y + s4.z + s4.w + s2.x + s2.y) * (1.f / 384.f) + RMS_EPS);
      if (nb < 512) {
        const int head = nb >> 6;
        const float* g = P.in[15] + layer * 64;
        float ss = (tile_ssq(acc[0][mt]) + tile_ssq(acc[1][mt])) * rc * rc;
        ss += lane_xor(ss, lane, 32);
        const float rstd = rsqrtf(ss * (1.f / 64.f) + RMS_EPS) * rc * QS_MLA;
        u16* dst = c.qb() + (size_t)s0 * 768 + ((size_t)head * Lb + l) * 96;
#pragma unroll
        for (int nt = 0; nt < 2; ++nt) {
          uint2 pk[4];
#pragma unroll
          for (int q4 = 0; q4 < 4; ++q4) {
            const float4 gg = *(const float4*)(g + nt * 32 + q4 * 8 + hh * 4);
            pk[q4] = pk4(acc[nt][mt][q4 * 4 + 0] * rstd * gg.x, acc[nt][mt][q4 * 4 + 1] * rstd * gg.y, acc[nt][mt][q4 * 4 + 2] * rstd * gg.z, acc[nt][mt][q4 * 4 + 3] * rstd * gg.w);
          }
          u16* d_ = dst + nt * 32 + hh * 16;
          *(uint4*)d_ = make_uint4(pk[0].x, pk[0].y, pk[1].x, pk[1].y);
          *(uint4*)(d_ + 8) = make_uint4(pk[2].x, pk[2].y, pk[3].x, pk[3].y);
        }
      } else {
        const float* g = P.in[17] + layer * 32;
#pragma unroll
        for (int nt = 0; nt < 2; ++nt) {
          const int head = ((nb - 512) >> 5) + nt;
          float ss = tile_ssq(acc[nt][mt]) * rc * rc;
          ss += lane_xor(ss, lane, 32);
          const float rstd = rsqrtf(ss * (1.f / 32.f) + RMS_EPS) * rc;
          rope_store(acc[nt][mt], rstd, g, c.rope() + (size_t)l * 32, QS_MLA, c.qb() + (size_t)s0 * 768 + ((size_t)head * Lb + l) * 96 + 64, hh);
        }
      }
    }
  }
};

struct EpiKV {
  const Ctx& c; int layer, m0, n0;
  DI void operator()(f32x16 (&acc)[2][4], int wm, int wn, int lane) const {
    const Params& P = c.P;
    const int r32 = lane & 31, hh = lane >> 5;
    const int nb = n0 + wn * 64, mb = m0 + wm * 128;
    const int b = seq_of(mb), Lb = seq_len(b), s0 = b * 4096;
#pragma unroll
    for (int mt = 0; mt < 4; ++mt) {
      const int tok = mb + mt * 32 + r32, l = tok - s0;
      const float4 s4 = *(const float4*)(c.ssq() + (size_t)tok * 16 + 4);
      const float4 s5 = *(const float4*)(c.ssq() + (size_t)tok * 16 + 8);
      const float rc = rsqrtf((s4.z + s4.w + s5.x + s5.y) * (1.f / 256.f) + RMS_EPS);
      if (nb < 512) {
        const int head = nb >> 6;
        const float* g = P.in[16] + layer * 64;
        float ss = (tile_ssq(acc[0][mt]) + tile_ssq(acc[1][mt])) * rc * rc;
        ss += lane_xor(ss, lane, 32);
        const float rstd = rsqrtf(ss * (1.f / 64.f) + RMS_EPS) * rc;
        u16* dst = c.kn() + (size_t)s0 * 512 + ((size_t)head * Lb + l) * 64;
#pragma unroll
        for (int nt = 0; nt < 2; ++nt) {
          uint2 pk[4];
#pragma unroll
          for (int q4 = 0; q4 < 4; ++q4) {
            const float4 gg = *(const float4*)(g + nt * 32 + q4 * 8 + hh * 4);
            pk[q4] = pk4(acc[nt][mt][q4 * 4 + 0] * rstd * gg.x, acc[nt][mt][q4 * 4 + 1] * rstd * gg.y, acc[nt][mt][q4 * 4 + 2] * rstd * gg.z, acc[nt][mt][q4 * 4 + 3] * rstd * gg.w);
          }
          u16* d_ = dst + nt * 32 + hh * 16;
          *(uint4*)d_ = make_uint4(pk[0].x, pk[0].y, pk[1].x, pk[1].y);
          *(uint4*)(d_ + 8) = make_uint4(pk[2].x, pk[2].y, pk[3].x, pk[3].y);
        }
      } else {
        const int head = (nb - 512) >> 6;
#pragma unroll
        for (int nt = 0; nt < 2; ++nt)
#pragma unroll
          for (int i = 0; i < 16; ++i) {
            const int d = nt * 32 + (i & 3) + 8 * (i >> 2) + 4 * hh;
            c.vt()[(size_t)s0 * 512 + (size_t)(head * 64 + d) * Lb + l] = bf1(acc[nt][mt][i] * rc);
          }
      }
    }
  }
};

struct EpiSloc {
  const Ctx& c; int gc0, g, n0;
  DI void operator()(f32x16 (&acc)[2][4], int wm, int wn, int lane) const {
    const int r32 = lane & 31, hh = lane >> 5;
#pragma unroll
    for (int mt = 0; mt < 4; ++mt) {
      const int chunk = gc0 + wm * 128 + mt * 32 + r32;
      float* dst = c.sloc() + ((size_t)chunk * 16 + g) * 256 + n0 + wn * 64;
#pragma unroll
      for (int nt = 0; nt < 2; ++nt)
#pragma unroll
        for (int q4 = 0; q4 < 4; ++q4)
          *(float4*)(dst + nt * 32 + q4 * 8 + hh * 4) = make_float4(acc[nt][mt][q4 * 4 + 0], acc[nt][mt][q4 * 4 + 1], acc[nt][mt][q4 * 4 + 2], acc[nt][mt][q4 * 4 + 3]);
    }
  }
};

DI float gelu_tanh(float x) {
  const float u = 0.7978845608028654f * (x + 0.044715f * x * x * x);
  const float e = __builtin_amdgcn_exp2f(2.f * LOG2E * u);
  const float th = 1.f - 2.f * __builtin_amdgcn_rcpf(e + 1.f);
  return 0.5f * x * (1.f + th);
}

struct EpiYs {
  const Ctx& c; int gc0, g, n0;
  DI void operator()(f32x16 (&acc)[2][4], int wm, int wn, int lane) const {
    const int r32 = lane & 31, hh = lane >> 5;
#pragma unroll
    for (int mt = 0; mt < 4; ++mt) {
      const int chunk = gc0 + wm * 128 + mt * 32 + r32;
#pragma unroll
      for (int nt = 0; nt < 2; ++nt)
#pragma unroll
        for (int q4 = 0; q4 < 4; ++q4) {
          const int n = n0 + wn * 64 + nt * 32 + q4 * 8 + hh * 4;
          const int t = n >> 4, cc = n & 15;
          *(uint2*)(c.ysact() + ((size_t)chunk * 32 + t) * 256 + g * 16 + cc) =
              pk4(gelu_tanh(acc[nt][mt][q4 * 4 + 0]), gelu_tanh(acc[nt][mt][q4 * 4 + 1]), gelu_tanh(acc[nt][mt][q4 * 4 + 2]), gelu_tanh(acc[nt][mt][q4 * 4 + 3]));
        }
    }
  }
};

struct EpiGlu {
  const Ctx& c; int layer, m0, n0;
  DI void operator()(f32x16 (&acc)[2][4], int wm, int wn, int lane) const {
    const int r32 = lane & 31, hh = lane >> 5;
    const float* gb = c.P.in[28] + layer * 256;
#pragma unroll
    for (int mt = 0; mt < 4; ++mt) {
      const int tok = m0 + wm * 128 + mt * 32 + r32;
#pragma unroll
      for (int nt = 0; nt < 2; ++nt) {
        uint2 pk[4];
#pragma unroll
        for (int q4 = 0; q4 < 4; ++q4) {
          const int n = n0 + wn * 64 + nt * 32 + q4 * 8 + hh * 4;
          const float4 bb = *(const float4*)(gb + n);
          const uint2 ys = *(const uint2*)(c.ysact() + (size_t)tok * 256 + n);
          pk[q4] = pk4(bflo(ys.x) * sigmoidf_(acc[nt][mt][q4 * 4 + 0] + bb.x), bfhi(ys.x) * sigmoidf_(acc[nt][mt][q4 * 4 + 1] + bb.y),
                       bflo(ys.y) * sigmoidf_(acc[nt][mt][q4 * 4 + 2] + bb.z), bfhi(ys.y) * sigmoidf_(acc[nt][mt][q4 * 4 + 3] + bb.w));
        }
        u16* d_ = c.r1() + (size_t)tok * 1024 + 768 + n0 + wn * 64 + nt * 32 + hh * 16;
        *(uint4*)d_ = make_uint4(pk[0].x, pk[0].y, pk[1].x, pk[1].y);
        *(uint4*)(d_ + 8) = make_uint4(pk[2].x, pk[2].y, pk[3].x, pk[3].y);
      }
    }
  }
};

struct EpiRes {
  const Ctx& c; int layer, m0, n0, gidx; bool from_input; int inst, ngi, nlayer, moff;
  DI void operator()(f32x16 (&acc)[2][4], int wm, int wn, int lane) const {
    const Params& P = c.P;
    const int r32 = lane & 31, hh = lane >> 5;
    const int mb = m0 + wm * 128;
    const int b = seq_of(mb);
    const float* gate = c.mod() + (size_t)(layer * 9 + b) * 6144 + gidx * 1024;
#pragma unroll
    for (int mt = 0; mt < 4; ++mt) {
      const int tok = mb + mt * 32 + r32;
      const float* xin = from_input ? (tok < TP ? P.in[0] + (size_t)tok * 1024 : P.in[1] + (size_t)(tok - TP) * 1024) : P.out + (size_t)tok * 1024;
      float* xo = P.out + (size_t)tok * 1024;
#pragma unroll
      for (int nt = 0; nt < 2; ++nt)
#pragma unroll
        for (int q4 = 0; q4 < 4; ++q4) {
          const int n = n0 + wn * 64 + nt * 32 + q4 * 8 + hh * 4;
          const float4 gg = *(const float4*)(gate + n);
          const float4 xv = *(const float4*)(xin + n);
          const float4 xn = make_float4(xv.x + gg.x * acc[nt][mt][q4 * 4 + 0], xv.y + gg.y * acc[nt][mt][q4 * 4 + 1], xv.z + gg.z * acc[nt][mt][q4 * 4 + 2], xv.w + gg.w * acc[nt][mt][q4 * 4 + 3]);
          if (inst < 0) *(float4*)(xo + n) = xn;
          acc[nt][mt][q4 * 4 + 0] = xn.x; acc[nt][mt][q4 * 4 + 1] = xn.y; acc[nt][mt][q4 * 4 + 2] = xn.z; acc[nt][mt][q4 * 4 + 3] = xn.w;
        }
    }
    if (inst < 0) return;
    float* red = (float*)(c.smem + 131072);
#pragma unroll
    for (int mt = 0; mt < 4; ++mt) {
      float ss = tile_ssq(acc[0][mt]) + tile_ssq(acc[1][mt]);
      ss += lane_xor(ss, lane, 32);
      if (hh == 0) red[(wm * 128 + mt * 32 + r32) * 4 + wn] = ss;
    }
    __syncthreads();
    const int tid = c.wv * 64 + lane;
    float* part = c.part() + (size_t)inst * TT * 4;
    unsigned* cnt = c.cnt() + inst * 192 + (m0 >> 8);
    if (tid < 256) {
      const float4 r = *(const float4*)(red + tid * 4);
      __hip_atomic_store(part + (size_t)(m0 + tid) * 4 + (n0 >> 8), r.x + r.y + r.z + r.w, __ATOMIC_RELAXED, __HIP_MEMORY_SCOPE_AGENT);
    }
    asm volatile("s_waitcnt vmcnt(0)" ::: "memory");
    __syncthreads();
    if (tid == 0) __hip_atomic_fetch_add(cnt, 1u, __ATOMIC_RELAXED, __HIP_MEMORY_SCOPE_AGENT);
#pragma unroll
    for (int mt = 0; mt < 4; ++mt) {
      float* xo = P.out + (size_t)(mb + mt * 32 + r32) * 1024;
#pragma unroll
      for (int nt = 0; nt < 2; ++nt)
#pragma unroll
        for (int q4 = 0; q4 < 4; ++q4)
          *(float4*)(xo + n0 + wn * 64 + nt * 32 + q4 * 8 + hh * 4) = make_float4(acc[nt][mt][q4 * 4 + 0], acc[nt][mt][q4 * 4 + 1], acc[nt][mt][q4 * 4 + 2], acc[nt][mt][q4 * 4 + 3]);
    }
    if (tid == 0) {
      int spins = 0;
      while (__hip_atomic_load(cnt, __ATOMIC_RELAXED, __HIP_MEMORY_SCOPE_AGENT) < 4u && ++spins < (1 << 22)) __builtin_amdgcn_s_sleep(1);
    }
    __syncthreads();
    const float* ng = P.in[ngi] + nlayer * 1024;
    const float* md = c.mod() + (size_t)(nlayer * 9 + b) * 6144 + moff;
#pragma unroll
    for (int mt = 0; mt < 4; ++mt) {
      const int tok = mb + mt * 32 + r32;
      const float* pp = part + (size_t)tok * 4;
      const float tot = __hip_atomic_load(pp, __ATOMIC_RELAXED, __HIP_MEMORY_SCOPE_AGENT) + __hip_atomic_load(pp + 1, __ATOMIC_RELAXED, __HIP_MEMORY_SCOPE_AGENT) +
                        __hip_atomic_load(pp + 2, __ATOMIC_RELAXED, __HIP_MEMORY_SCOPE_AGENT) + __hip_atomic_load(pp + 3, __ATOMIC_RELAXED, __HIP_MEMORY_SCOPE_AGENT);
      const float rstd = rsqrtf(tot * (1.f / 1024.f) + RMS_EPS);
#pragma unroll
      for (int nt = 0; nt < 2; ++nt) {
        uint2 pk[4];
#pragma unroll
        for (int q4 = 0; q4 < 4; ++q4) {
          const int n = n0 + wn * 64 + nt * 32 + q4 * 8 + hh * 4;
          const float4 gg = *(const float4*)(ng + n), sh = *(const float4*)(md + n), scl = *(const float4*)(md + 1024 + n);
          pk[q4] = pk4(acc[nt][mt][q4 * 4 + 0] * rstd * gg.x * (1.f + scl.x) + sh.x, acc[nt][mt][q4 * 4 + 1] * rstd * gg.y * (1.f + scl.y) + sh.y,
                       acc[nt][mt][q4 * 4 + 2] * rstd * gg.z * (1.f + scl.z) + sh.z, acc[nt][mt][q4 * 4 + 3] * rstd * gg.w * (1.f + scl.w) + sh.w);
        }
        u16* d = c.r1() + (size_t)tok * 1024 + n0 + wn * 64 + nt * 32 + hh * 16;
        *(uint4*)d = make_uint4(pk[0].x, pk[0].y, pk[1].x, pk[1].y);
        *(uint4*)(d + 8) = make_uint4(pk[2].x, pk[2].y, pk[3].x, pk[3].y);
      }
    }
  }
};

struct EpiSwiglu {
  const Ctx& c; int m0, n0;
  DI void operator()(f32x16 (&acc)[2][4], int wm, int wn, int lane) const {
    const int r32 = lane & 31, hh = lane >> 5;
    const int grp = (n0 + wn * 64) >> 6;
#pragma unroll
    for (int mt = 0; mt < 4; ++mt) {
      const int tok = m0 + wm * 128 + mt * 32 + r32;
      float o[16];
#pragma unroll
      for (int i = 0; i < 16; ++i) {
        const float gt = acc[0][mt][i], up = acc[1][mt][i];
        o[i] = gt * sigmoidf_(gt) * up;
      }
      u16* d = c.hid() + (size_t)tok * FH + grp * 32 + hh * 16;
      *(uint4*)d = make_uint4(pk2(o[0], o[1]), pk2(o[2], o[3]), pk2(o[4], o[5]), pk2(o[6], o[7]));
      *(uint4*)(d + 8) = make_uint4(pk2(o[8], o[9]), pk2(o[10], o[11]), pk2(o[12], o[13]), pk2(o[14], o[15]));
    }
  }
};

DI bf16x8 pack8(const f32x16& p, int s2) {
  uint4 u;
  if (s2 == 0) { u.x = pk2(p[0], p[1]); u.y = pk2(p[2], p[3]); u.z = pk2(p[4], p[5]); u.w = pk2(p[6], p[7]); }
  else { u.x = pk2(p[8], p[9]); u.y = pk2(p[10], p[11]); u.z = pk2(p[12], p[13]); u.w = pk2(p[14], p[15]); }
  return __builtin_bit_cast(bf16x8, u);
}

constexpr int KP = 104;
constexpr int VP = 136;
DI void mla_item(const Ctx& c, int b, int head, int qblk) {
  const int tid = otid(c.wv), lane = tid & 63, wave = tid >> 6;
  const int r32 = lane & 31, hh = lane >> 5;
  const int Lb = seq_len(b), s0 = b * 4096;
  u16(*Ks)[128][KP] = (u16(*)[128][KP])c.smem;
  u16(*Vs)[64][VP] = (u16(*)[64][VP])(c.smem + 2 * 128 * KP * 2);
  const u16* Q = c.qb() + (size_t)s0 * 768 + (size_t)head * Lb * 96;
  const u16* KN = c.kn() + (size_t)s0 * 512 + (size_t)head * Lb * 64;
  const u16* KR = c.kr() + (size_t)s0 * 32;
  const u16* VT = c.vt() + (size_t)s0 * 512 + (size_t)(head * 64) * Lb;
  const int q0 = qblk * 512 + wave * 64;
  bf16x8 qf[2][6];
#pragma unroll
  for (int qt = 0; qt < 2; ++qt)
#pragma unroll
    for (int ks = 0; ks < 6; ++ks) qf[qt][ks] = ldg8(Q + (size_t)(q0 + qt * 32 + r32) * 96 + ks * 16 + hh * 8);
  f32x16 o[2][2];
#pragma unroll
  for (int a = 0; a < 2; ++a)
#pragma unroll
    for (int bq = 0; bq < 2; ++bq) zero_acc(o[a][bq]);
  float lsum[2] = {0.f, 0.f};
  uint4 rk0, rk1, rk2, rv0, rv1;
  const int kkey0 = tid >> 3, kpart0 = tid & 7;
  const int kkey2 = tid >> 2, kpart2 = 8 + (tid & 3);
  const int vd0 = tid >> 4, vkc = tid & 15;
  const unsigned ko0 = kkey0 * 64 + kpart0 * 8, ko1 = ko0 + 64 * 64, ko2 = kkey2 * 32 + (tid & 3) * 8;
  const unsigned vo0 = (unsigned)vd0 * Lb + vkc * 8, vo1 = (unsigned)(vd0 + 32) * Lb + vkc * 8;
#define MGLOADK(k0_)                                       \
  {                                                        \
    const int k0__ = (k0_);                                \
    const u16* knb__ = KN + (size_t)k0__ * 64;             \
    const u16* krb__ = KR + (size_t)k0__ * 32;             \
    rk0 = *(const uint4*)(knb__ + ko0);                    \
    rk1 = *(const uint4*)(knb__ + ko1);                    \
    rk2 = *(const uint4*)(krb__ + ko2);                    \
  }
#define MGLOADV(k0_)                                       \
  {                                                        \
    const u16* vtb__ = VT + (k0_);                         \
    rv0 = *(const uint4*)(vtb__ + vo0);                    \
    rv1 = *(const uint4*)(vtb__ + vo1);                    \
  }
#define MSTOREK(buf_)                                  \
  {                                                    \
    const int b__ = (buf_);                            \
    *(uint4*)&Ks[b__][kkey0][kpart0 * 8] = rk0;        \
    *(uint4*)&Ks[b__][kkey0 + 64][kpart0 * 8] = rk1;   \
    *(uint4*)&Ks[b__][kkey2][kpart2 * 8] = rk2;        \
  }
#define MSTOREV(buf_)                                  \
  {                                                    \
    const int b__ = (buf_);                            \
    *(uint4*)&Vs[b__][vd0][vkc * 8] = rv0;             \
    *(uint4*)&Vs[b__][vd0 + 32][vkc * 8] = rv1;        \
  }
  const int ntile = Lb >> 7;
  __syncthreads();
  MGLOADK(0);
  MGLOADV(0);
  MSTOREK(0);
  MSTOREV(0);
  __syncthreads();
  const int pr = pi32(r32);
#pragma unroll 1
  for (int kt = 0; kt < ntile; ++kt) {
    const int buf = kt & 1;
    if (kt + 1 < ntile) MGLOADK((kt + 1) * 128);
#pragma unroll 2
    for (int kk = 0; kk < 4; ++kk) {
      f32x16 s[2];
      zero_acc(s[0]); zero_acc(s[1]);
#pragma unroll
      for (int ks = 0; ks < 6; ++ks) {
        const bf16x8 kf = *(const bf16x8*)&Ks[buf][kk * 32 + pr][ks * 16 + hh * 8];
        s[0] = MFMA(kf, qf[0][ks], s[0]);
        s[1] = MFMA(kf, qf[1][ks], s[1]);
      }
      bf16x8 pf[2][2];
#pragma unroll
      for (int qt = 0; qt < 2; ++qt) {
        float ls = 0.f;
#pragma unroll
        for (int i = 0; i < 16; ++i) { s[qt][i] = __builtin_amdgcn_exp2f(s[qt][i]); ls += s[qt][i]; }
        lsum[qt] += ls;
        pf[qt][0] = pack8(s[qt], 0);
        pf[qt][1] = pack8(s[qt], 1);
      }
#pragma unroll
      for (int dt = 0; dt < 2; ++dt)
#pragma unroll
        for (int s2 = 0; s2 < 2; ++s2) {
          const bf16x8 vf = *(const bf16x8*)&Vs[buf][dt * 32 + r32][kk * 32 + s2 * 16 + hh * 8];
          o[dt][0] = MFMA(vf, pf[0][s2], o[dt][0]);
          o[dt][1] = MFMA(vf, pf[1][s2], o[dt][1]);
        }
      if (kk == 1 && kt + 1 < ntile) {
        MSTOREK(buf ^ 1);
        MGLOADV((kt + 1) * 128);
      }
    }
    if (kt + 1 < ntile) MSTOREV(buf ^ 1);
    __syncthreads();
  }
#undef MGLOADK
#undef MGLOADV
#undef MSTOREK
#undef MSTOREV
  const int lane2 = otid(c.wv) & 63, r32b = lane2 & 31, hhb = lane2 >> 5;
#pragma unroll
  for (int qt = 0; qt < 2; ++qt) {
    float l = lsum[qt];
    l += lane_xor(l, lane2, 32);
    const float inv = 1.f / l;
    const int tok = b * 4096 + qblk * 512 + c.wv * 64 + qt * 32 + r32b;
    u16* dst = c.r1() + (size_t)tok * 1024 + 256 + head * 64;
#pragma unroll
    for (int dt = 0; dt < 2; ++dt)
#pragma unroll
      for (int q4 = 0; q4 < 4; ++q4)
        *(uint2*)(dst + dt * 32 + hhb * 16 + q4 * 4) = pk4(o[dt][qt][q4 * 4 + 0] * inv, o[dt][qt][q4 * 4 + 1] * inv, o[dt][qt][q4 * 4 + 2] * inv, o[dt][qt][q4 * 4 + 3] * inv);
  }
}

DI void na_item(const Ctx& c, const float* __restrict__ bias, int b, int row, int head, int qt) {
  const int lane = otid(c.wv) & 63;
  const int r32 = lane & 31, hh = lane >> 5;
  const int Lb = seq_len(b), s0 = b * 4096, rows = Lb >> 6;
  const int rstart = min(max(row - 4, 0), rows - 8);
  const int tok0 = s0 + row * 64 + qt * 32;
  bf16x8 qf[4];
#pragma unroll
  for (int ks = 0; ks < 4; ++ks) qf[ks] = ldg8(c.naq() + (size_t)(tok0 + r32) * 256 + head * 64 + ks * 16 + hh * 8);
  f32x16 o[2];
  zero_acc(o[0]); zero_acc(o[1]);
  float lsum = 0.f;
  const int pr = pi32(r32);
  const int qc = qt * 32 + r32;
  const int cs = min(max(qc - 8, 0), 48);
  const u16* VT = c.navt() + (size_t)s0 * 256 + (size_t)(head * 64) * Lb;
#pragma unroll 1
  for (int kri = 0; kri < 8; ++kri) {
    const int krow = rstart + kri;
    const float* bl = bias + (head * 15 + (krow - row + 7)) * 31;
#pragma unroll
    for (int kk = 0; kk < 2; ++kk) {
      const u16* kp = c.nak() + (size_t)(s0 + krow * 64 + kk * 32 + pr) * 256 + head * 64 + hh * 8;
      bf16x8 kf[4];
#pragma unroll
      for (int ks = 0; ks < 4; ++ks) kf[ks] = ldg8(kp + ks * 16);
      bf16x8 vf[2][2];
#pragma unroll
      for (int dt = 0; dt < 2; ++dt)
#pragma unroll
        for (int s2 = 0; s2 < 2; ++s2) vf[dt][s2] = ldg8(VT + (size_t)(dt * 32 + r32) * Lb + krow * 64 + kk * 32 + s2 * 16 + hh * 8);
      f32x16 s;
      zero_acc(s);
#pragma unroll
      for (int ks = 0; ks < 4; ++ks) s = MFMA(kf[ks], qf[ks], s);
      float ls = 0.f;
#pragma unroll
      for (int i = 0; i < 16; ++i) {
        const int kc = kk * 32 + 16 * ((i >> 3) & 1) + 8 * hh + 4 * ((i >> 2) & 1) + (i & 3);
        const bool valid = (kc >= cs) && (kc < cs + 16);
        const int bi = min(max(kc - qc + 15, 0), 30);
        const float p = valid ? __builtin_amdgcn_exp2f(s[i] + bl[bi]) : 0.f;
        s[i] = p; ls += p;
      }
      lsum += ls;
      const bf16x8 pf0 = pack8(s, 0), pf1 = pack8(s, 1);
#pragma unroll
      for (int dt = 0; dt < 2; ++dt) {
        o[dt] = MFMA(vf[dt][0], pf0, o[dt]);
        o[dt] = MFMA(vf[dt][1], pf1, o[dt]);
      }
    }
  }
  float l = lsum;
  l += lane_xor(l, lane, 32);
  const float inv = 1.f / l;
  u16* dst = c.r1() + (size_t)(tok0 + r32) * 1024 + head * 64;
#pragma unroll
  for (int dt = 0; dt < 2; ++dt)
#pragma unroll
    for (int q4 = 0; q4 < 4; ++q4)
      *(uint2*)(dst + dt * 32 + hh * 16 + q4 * 4) = pk4(o[dt][q4 * 4 + 0] * inv, o[dt][q4 * 4 + 1] * inv, o[dt][q4 * 4 + 2] * inv, o[dt][q4 * 4 + 3] * inv);
}

DI void carry_item(const Ctx& c, int layer, int it4) {
  const int tid = otid(c.wv);
  const int item = it4 * 4 + (tid >> 7);
  const int b = item >> 4, g = item & 15;
  const int dir = (tid >> 6) & 1, p = tid & 63;
  const int nch = seq_len(b) >> 5, gc0 = b * 128;
  const float2 lt = c.etab()[((size_t)((layer * 16 + g) * 2 + dir) * 64 + p) * 33 + 32];
  const float* __restrict__ sl_base = c.sloc() + (size_t)g * 256 + dir * 128 + p * 2;
  u16* __restrict__ ca_base = c.carry() + (size_t)g * 256 + dir * 128 + p * 2;
  float cr = 0.f, ci = 0.f;
  for (int k0 = 0; k0 < nch; k0 += 16) {
    float2 sl[16];
#pragma unroll
    for (int u = 0; u < 16; ++u) {
      const int ch = gc0 + (dir == 0 ? k0 + u : nch - 1 - (k0 + u));
      sl[u] = *(const float2*)(sl_base + (size_t)ch * 4096);
    }
#pragma unroll
    for (int u = 0; u < 16; ++u) {
      const int ch = gc0 + (dir == 0 ? k0 + u : nch - 1 - (k0 + u));
      *(unsigned*)(ca_base + (size_t)ch * 4096) = pk2(cr, ci);
      const float nr = lt.x * cr - lt.y * ci + sl[u].x;
      const float ni = lt.x * ci + lt.y * cr + sl[u].y;
      cr = nr; ci = ni;
    }
  }
}

template <bool COOP>
__global__ void __launch_bounds__(512, 2) mega(Params P, int ph_lo, int ph_hi, int dupmask) {
  __shared__ __attribute__((aligned(16))) unsigned char smem[2 * 2 * 256 * LP * 2];
  unsigned char* ws = P.ws;
  Ctx c{P, smem, ws, __builtin_amdgcn_readfirstlane((int)(threadIdx.x >> 6))};
  constexpr bool fuse = true;
#pragma unroll 1
  for (int ph2 = ph_lo * 2; ph2 < ph_hi * 2; ++ph2) {
    const int ph = ph2 >> 1;
    if ((ph2 & 1) && !(ph > 0 && ((dupmask >> ((ph - 1) % 10)) & 1))) continue;
    if (ph == 0) {
      phase_init(c);
    } else {
      const int l = (ph - 1) / 10, sub = (ph - 1) % 10;
      if (fuse && (sub == 7 || (sub == 0 && l > 0))) continue;
      int pg = -1, pl = 0, pstart = 0, pstride = 1;
      switch (sub) {
#if !defined(ONLY_SUB) || ONLY_SUB == 0
        case 0:
          if (l == 0) { pg = 0; pl = 0; pstart = (int)blockIdx.x; pstride = (int)gridDim.x; }
          break;
#endif
#if !defined(ONLY_SUB) || ONLY_SUB == 1
        case 1: {
          const XcdOrder xo(192, 7, 7);
          gemm_stream(smem, c.wv, xo.lb, xo.nlb, xo.total, 1024, 16,
            [&](int s) { int m, n; xo.decode(s, m, n); return TileDesc{ADesc{c.r1() + (size_t)m * 256 * 1024, 1024, nullptr, 0, 1 << 30}, c.win() + (size_t)n * 256 * 1024}; },
            [&](int s) { int m, n; xo.decode(s, m, n); return EpiG1{c, l, m * 256, n * 256}; });
          pg = 1; pl = l; pstart = tail_slot(xo.total, pstride);
        } break;
#endif
#if !defined(ONLY_SUB) || ONLY_SUB == 2
        case 2: {
          {
            const XcdOrder xo(192, 3, 3);
            gemm_stream(smem, c.wv, xo.lb, xo.nlb, xo.total, 384, 6,
              [&](int s) { int m, n; xo.decode(s, m, n); return TileDesc{ADesc{c.cq() + (size_t)m * 256 * 384, 384, nullptr, 0, 1 << 30}, c.wuq() + (size_t)n * 256 * 384}; },
              [&](int s) { int m, n; xo.decode(s, m, n); return EpiQ{c, l, m * 256, n * 256}; });
          }
          {
            const XcdOrder xo(192, 4, 4);
            gemm_stream(smem, c.wv, xo.lb, xo.nlb, xo.total, 256, 4,
              [&](int s) { int m, n; xo.decode(s, m, n); return TileDesc{ADesc{c.ckv() + (size_t)m * 256 * 256, 256, nullptr, 0, 1 << 30}, c.wukv() + (size_t)n * 256 * 256}; },
              [&](int s) { int m, n; xo.decode(s, m, n); return EpiKV{c, l, m * 256, n * 256}; });
          }
          gemm_stream(smem, c.wv, (int)blockIdx.x, (int)gridDim.x, 96, 512, 8,
            [&](int it) { const int g = it / 6, mt = it % 6; return TileDesc{ADesc{c.ub() + ((size_t)g * 1536 + mt * 256) * 512, 512, nullptr, 0, 1 << 30}, c.mint() + (size_t)g * 256 * 512}; },
            [&](int it) { const int g = it / 6, mt = it % 6; return EpiSloc{c, mt * 256, g, 0}; });
          const int tid = otid(c.wv);
          __syncthreads();
          float* bias = (float*)smem;
          for (int i = tid; i < 4 * 15 * 31; i += NTH) bias[i] = P.in[10][(size_t)l * 4 * 15 * 31 + i] * LOG2E;
          __syncthreads();
          for (int it = blockIdx.x; it < 768; it += gridDim.x) {
            int b, row;
            if (it < 512) { b = it >> 6; row = it & 63; } else { b = 8; row = it - 512; }
            na_item(c, bias, b, row, tid >> 7, (tid >> 6) & 1);
          }
          {
            const int lb = blockIdx.x >> 3, nlb = gridDim.x >> 3, xcd = blockIdx.x & 7;
            pg = 2; pl = l;
            if (nlb > 12) { pstride = 8 * (nlb - 12); pstart = lb < 12 ? (1 << 30) : xcd * (nlb - 12) + (lb - 12); }
            else { pstride = (int)gridDim.x; pstart = (int)blockIdx.x; }
          }
        } break;
#endif
#if !defined(ONLY_SUB) || ONLY_SUB == 3
        case 3: {
          for (int it = blockIdx.x; it < 36; it += gridDim.x) carry_item(c, l, it);
          for (int it = blockIdx.x; it < 768; it += gridDim.x) {
            int b, head, qblk;
            if (it < 256) { b = 8; head = it & 7; qblk = it >> 3; }
            else { const int j = it - 256; head = j & 7; b = (j >> 3) >> 3; qblk = (j >> 3) & 7; }
            mla_item(c, b, head, qblk);
          }
        } break;
#endif
#if !defined(ONLY_SUB) || ONLY_SUB == 4
        case 4:
          gemm_stream(smem, c.wv, (int)blockIdx.x, (int)gridDim.x, 192, 768, 12,
            [&](int it) { const int n = it & 1, u = it >> 1, g = u / 6, gc0 = (u % 6) * 256;
                          return TileDesc{ADesc{c.ub() + ((size_t)g * 1536 + gc0) * 512, 512, c.carry() + ((size_t)gc0 * 16 + g) * 256, 4096, 8}, c.kt() + ((size_t)g * 512 + n * 256) * 768}; },
            [&](int it) { const int n = it & 1, u = it >> 1, g = u / 6, gc0 = (u % 6) * 256; return EpiYs{c, gc0, g, n * 256}; });
          break;
#endif
#if !defined(ONLY_SUB) || ONLY_SUB == 5
        case 5: {
          const XcdOrder xo(192, 1, 1);
          gemm_stream(smem, c.wv, xo.lb, xo.nlb, xo.total, 256, 4,
            [&](int s) { int m, n; xo.decode(s, m, n); return TileDesc{ADesc{c.ysact() + (size_t)m * 256 * 256, 256, nullptr, 0, 1 << 30}, c.wglu()}; },
            [&](int s) { int m, n; xo.decode(s, m, n); return EpiGlu{c, l, m * 256, 0}; });
        } break;
#endif
#if !defined(ONLY_SUB) || ONLY_SUB == 6
        case 6: {
          const XcdOrder xo(192, 4, 4);
          gemm_stream(smem, c.wv, xo.lb, xo.nlb, xo.total, 1024, 16,
            [&](int s) { int m, n; xo.decode(s, m, n); return TileDesc{ADesc{c.r1() + (size_t)m * 256 * 1024, 1024, nullptr, 0, 1 << 30}, c.wout() + (size_t)n * 256 * 1024}; },
            [&](int s) { int m, n; xo.decode(s, m, n); return EpiRes{c, l, m * 256, n * 256, 2, l == 0, fuse ? l * 2 : -1, 30, l, 3072}; });
        } break;
#endif
#if !defined(ONLY_SUB) || ONLY_SUB == 7
        case 7: break;
#endif
#if !defined(ONLY_SUB) || ONLY_SUB == 8
        case 8: {
          const XcdOrder xo(192, 22, 11);
          gemm_stream(smem, c.wv, xo.lb, xo.nlb, xo.total, 1024, 16,
            [&](int s) { int m, n; xo.decode(s, m, n); return TileDesc{ADesc{c.r1() + (size_t)m * 256 * 1024, 1024, nullptr, 0, 1 << 30}, c.wgu() + (size_t)n * 256 * 1024}; },
            [&](int s) { int m, n; xo.decode(s, m, n); return EpiSwiglu{c, m * 256, n * 256}; });
          if (l + 1 < DEPTH) { pg = 0; pl = l + 1; pstart = tail_slot(xo.total, pstride); }
        } break;
#endif
#if !defined(ONLY_SUB) || ONLY_SUB == 9
        case 9: {
          const XcdOrder xo(192, 4, 4);
          gemm_stream(smem, c.wv, xo.lb, xo.nlb, xo.total, FH, 44,
            [&](int s) { int m, n; xo.decode(s, m, n); return TileDesc{ADesc{c.hid() + (size_t)m * 256 * FH, FH, nullptr, 0, 1 << 30}, c.wdn() + (size_t)n * 256 * FH}; },
            [&](int s) { int m, n; xo.decode(s, m, n); return EpiRes{c, l, m * 256, n * 256, 5, false, (fuse && l + 1 < DEPTH) ? l * 2 + 1 : -1, 6, l + 1, 0}; });
        } break;
#endif
      }
      if (pg >= 0) prep_items(c, pl, pg, pstart, pstride);
      if (sub == 0) norm_rows(c, 0, 0);
    }
    if (COOP) {
      if (ph2 + 1 < ph_hi * 2) cg::this_grid().sync();
    }
  }
}

extern "C" void kernel_launch(void* const* d_in, const int* in_sizes, int n_in, void* d_out, int out_size, void* d_ws, size_t ws_size, hipStream_t stream) {
  if (ws_size < O_END) { fprintf(stderr, "workspace too small: %zu < %zu\n", ws_size, (size_t)O_END); return; }
  Params p{};
  for (int i = 0; i < 34; ++i) p.in[i] = (const float*)d_in[i];
  p.out = (float*)d_out;
  p.ws = (unsigned char*)d_ws;
  static int grid_blocks = 0;
  if (!grid_blocks) {
    int dev = 0, cus = 0, per_cu = 0;
    (void)hipGetDevice(&dev);
    (void)hipDeviceGetAttribute(&cus, hipDeviceAttributeMultiprocessorCount, dev);
    (void)hipOccupancyMaxActiveBlocksPerMultiprocessor(&per_cu, mega<true>, NTH, 0);
    if (per_cu > 1) per_cu = 1;
    grid_blocks = (cus * per_cu) & ~31;
  }
  int lo = 0, hi = 41, dup = DUPMASK;
  void* args[] = {&p, &lo, &hi, &dup};
  hipError_t e = hipLaunchCooperativeKernel((void*)mega<true>, dim3(grid_blocks), dim3(NTH), args, 0, stream);
  if (e != hipSuccess) fprintf(stderr, "cooperative launch failed: %s (grid %d)\n", hipGetErrorString(e), grid_blocks);
}
```
